# Optimizing an MI355X kernel written in HIP

```python
import jax, jax.numpy as jnp
from jax import lax
import numpy as np

D_MODEL = 1024
BATCH = 16
SEQ = 2048
DEPTH = 2

GRID_W = 64
D_MIX = D_MODEL
D_ATTN = D_MIX // 2
N_HEADS = 8
HEAD_DIM = D_ATTN // N_HEADS
WIN_ROWS = 8
WIN_COLS = 16
D_POOL = D_MIX - D_ATTN
POOL_WINDOWS = (2, 4, 8, 16)
N_POOL_GROUPS = len(POOL_WINDOWS)
POOL_GROUP_DIM = D_POOL // N_POOL_GROUPS
D_IN_PROJ = 3 * D_ATTN + D_POOL
D_FF = 2816
RMS_EPS = 1e-6
NEG_INF = -1e30

kernel_name = "hybrid_natten_pool_macaron_block"


def rms_norm(x, g):
    xf = x.astype(jnp.float32)
    y = xf * lax.rsqrt(jnp.mean(xf * xf, axis=-1, keepdims=True) + RMS_EPS)
    return (y * g.astype(jnp.float32)).astype(x.dtype)


def swiglu(h, w_gate, w_up, w_down):
    return (jax.nn.silu(h @ w_gate) * (h @ w_up)) @ w_down


def neighborhood_attention(q, k, v, rpb):
    b, s, h, dh = q.shape
    rows = s // GRID_W
    kh = min(WIN_ROWS, rows)
    qg = q.reshape(b, rows, GRID_W, h, dh) * (dh ** -0.5)
    kg = k.reshape(b, rows, GRID_W, h, dh)
    vg = v.reshape(b, rows, GRID_W, h, dh)
    cols = jnp.arange(GRID_W)
    col_start = jnp.clip(cols - WIN_COLS // 2, 0, GRID_W - WIN_COLS)
    col_mask = (cols[None, :] >= col_start[:, None]) & (cols[None, :] < col_start[:, None] + WIN_COLS)
    dc_idx = jnp.clip(cols[None, :] - cols[:, None] + WIN_COLS - 1, 0, 2 * WIN_COLS - 2)
    rpb_f = rpb.astype(jnp.float32)

    def row_block(r):
        rs = jnp.clip(r - kh // 2, 0, rows - kh)
        q_r = lax.dynamic_index_in_dim(qg, r, axis=1, keepdims=False)
        k_r = lax.dynamic_slice_in_dim(kg, rs, kh, axis=1)
        v_r = lax.dynamic_slice_in_dim(vg, rs, kh, axis=1)
        dr_idx = rs + jnp.arange(kh) - r + WIN_ROWS - 1
        bias = rpb_f[:, dr_idx][:, :, dc_idx]
        bias = jnp.transpose(bias, (0, 2, 1, 3))
        scores = jnp.einsum("bqhd,bikhd->bhqik", q_r, k_r).astype(jnp.float32) + bias[None]
        scores = jnp.where(col_mask[None, None, :, None, :], scores, NEG_INF)
        probs = jax.nn.softmax(scores.reshape(b, h, GRID_W, kh * GRID_W), axis=-1)
        probs = probs.reshape(b, h, GRID_W, kh, GRID_W).astype(v.dtype)
        return jnp.einsum("bhqik,bikhd->bqhd", probs, v_r)

    out = lax.map(row_block, jnp.arange(rows))
    return jnp.transpose(out, (1, 0, 2, 3, 4)).reshape(b, s, h * dh)


def multiscale_pool(p, w_pool, scale):
    b, s, c = p.shape
    pf = p.astype(jnp.float32)
    csum = jnp.concatenate([jnp.zeros((b, 1, c), jnp.float32), jnp.cumsum(pf, axis=1)], axis=1)
    t = jnp.arange(s)
    outs = []
    for g, w in enumerate(POOL_WINDOWS):
        sl = slice(g * POOL_GROUP_DIM, (g + 1) * POOL_GROUP_DIM)
        lo = jnp.clip(t - w // 2, 0, s)
        hi = jnp.clip(t - w // 2 + w, 0, s)
        cg = csum[:, :, sl]
        mean = (cg[:, hi] - cg[:, lo]) / (hi - lo).astype(jnp.float32)[None, :, None]
        outs.append(mean - pf[:, :, sl])
    d = jnp.stack(outs, axis=2).astype(p.dtype)
    y = jnp.einsum("bsgc,gcd->bsgd", d, w_pool).reshape(b, s, c)
    return y * scale


def setup_inputs(seed: int = 0) -> dict:
    key = jax.random.key(seed)
    ks = jax.random.split(key, 20)
    f32 = jnp.float32

    def nrm(k, shape, fan_in):
        return jax.random.normal(k, shape, f32) * (fan_in ** -0.5)

    def gain(k, shape):
        return 1.0 + 0.05 * jax.random.normal(k, shape, f32)

    return {
        "x": jax.random.normal(ks[0], (BATCH, SEQ, D_MODEL), f32),
        "ffn1_norm": gain(ks[1], (DEPTH, D_MODEL)),
        "ffn1_w_gate": nrm(ks[2], (DEPTH, D_MODEL, D_FF), D_MODEL),
        "ffn1_w_up": nrm(ks[3], (DEPTH, D_MODEL, D_FF), D_MODEL),
        "ffn1_w_down": nrm(ks[4], (DEPTH, D_FF, D_MODEL), D_FF),
        "mix_norm": gain(ks[5], (DEPTH, D_MODEL)),
        "w_in": nrm(ks[6], (DEPTH, D_MODEL, D_IN_PROJ), D_MODEL),
        "rpb": 0.5 * jax.random.normal(ks[7], (DEPTH, N_HEADS, 2 * WIN_ROWS - 1, 2 * WIN_COLS - 1), f32),
        "w_pool": nrm(ks[8], (DEPTH, N_POOL_GROUPS, POOL_GROUP_DIM, POOL_GROUP_DIM), POOL_GROUP_DIM),
        "pool_scale": gain(ks[9], (DEPTH, D_POOL)),
        "w_out": nrm(ks[10], (DEPTH, D_MIX, D_MODEL), D_MIX),
        "ffn2_norm": gain(ks[11], (DEPTH, D_MODEL)),
        "ffn2_w_gate": nrm(ks[12], (DEPTH, D_MODEL, D_FF), D_MODEL),
        "ffn2_w_up": nrm(ks[13], (DEPTH, D_MODEL, D_FF), D_MODEL),
        "ffn2_w_down": nrm(ks[14], (DEPTH, D_FF, D_MODEL), D_FF),
        "final_norm": gain(ks[15], (D_MODEL,)),
    }


def reference(x, ffn1_norm, ffn1_w_gate, ffn1_w_up, ffn1_w_down, mix_norm, w_in, rpb,
              w_pool, pool_scale, w_out, ffn2_norm, ffn2_w_gate, ffn2_w_up, ffn2_w_down,
              final_norm):
    b, s, _ = x.shape
    for l in range(DEPTH):
        x = x + 0.5 * swiglu(rms_norm(x, ffn1_norm[l]), ffn1_w_gate[l], ffn1_w_up[l], ffn1_w_down[l])
        h = rms_norm(x, mix_norm[l])
        z = h @ w_in[l]
        q = z[..., 0:D_ATTN].reshape(b, s, N_HEADS, HEAD_DIM)
        k = z[..., D_ATTN:2 * D_ATTN].reshape(b, s, N_HEADS, HEAD_DIM)
        v = z[..., 2 * D_ATTN:3 * D_ATTN].reshape(b, s, N_HEADS, HEAD_DIM)
        p = z[..., 3 * D_ATTN:]
        a = neighborhood_attention(q, k, v, rpb[l])
        m = multiscale_pool(p, w_pool[l], pool_scale[l])
        x = x + jnp.concatenate([a, m], axis=-1) @ w_out[l]
        x = x + 0.5 * swiglu(rms_norm(x, ffn2_norm[l]), ffn2_w_gate[l], ffn2_w_up[l], ffn2_w_down[l])
    return rms_norm(x, final_norm)
```

```cpp
#include <hip/hip_runtime.h>
#include <hip/hip_cooperative_groups.h>
#include <cstdio>
#include <cstdint>
namespace cg = cooperative_groups;
#define DUP_PRO 0
#define DUP_UP 0
#define DUP_ATTN 0
#define DUP_DOWN 0
#define DUP_IN 0
#define DUP_WOUT 0
#define ATT_PROBE_MASK 3
#define DUP_DOWN_NULL 0
namespace pg8 {
#define PG8_LAS __attribute__((address_space(3)))
typedef unsigned short bf16_t;
typedef short bf16x8 __attribute__((ext_vector_type(8)));
typedef float f32x4 __attribute__((ext_vector_type(4)));
typedef unsigned u32x4 __attribute__((ext_vector_type(4)));
constexpr int BM = 256, BK = 64, HALF = 128, HTB = HALF * BK * 2  , STAGE_BYTES = 8 * HTB, NXCD = 8, WGM = 8;

__host__ __device__ __forceinline__ int lds_byte(int r, int c) { const int st = (r >> 4) * 2 + (c >> 5), rr = r & 15, cc = c & 31, ob = rr * 64 + cc * 2; return st * 1024 + (ob ^ (((ob >> 9) & 1) << 5)); }
__host__ __device__ __forceinline__ void stage_rc(int b, int& R, int& C) { const int st = b / 1024, sb = b % 1024, swz = sb ^ (((sb >> 9) & 1) << 5); R = (st >> 1) * 16 + swz / 64; C = (st & 1) * 32 + (swz % 64) / 2; }
__host__ __device__ __forceinline__ int perm32(int rho) { const int n = rho >> 4, i = rho & 15; return 8 * (i >> 2) + 4 * n + (i & 3); }

struct Unit { int pm, pn, swp; };
struct Gemm { const bf16_t* A; const bf16_t* Bt; int M, N, K; };

struct StaticOrder {
    int nM, nN, nwg, G, c;
    __host__ __device__ void init(int M, int N, int G_, int c_) { nM = M / BM; nN = N / BM; nwg = nM * nN; G = G_; c = c_; }
    __host__ __device__ bool next(int i, Unit& u) const {
        const long L = (long)i * G + c; if (L >= nwg) return false;
        int wgid = (int)L; { const int q = nwg / NXCD, r = nwg % NXCD, xcd = wgid % NXCD, off = wgid / NXCD; wgid = (xcd < r ? xcd * (q + 1) : r * (q + 1) + (xcd - r) * q) + off; }
        const int nig = WGM * nN, gid = wgid / nig, fm = gid * WGM, gsz = (nM - fm) < WGM ? (nM - fm) : WGM;
        u.pm = fm + ((wgid % nig) % gsz); u.pn = (wgid % nig) / gsz; u.swp = 0; return true;
    }
    __device__ __forceinline__ void a_ready(const Unit&) const {}
    __device__ __forceinline__ void done(const Unit&) const {}
};

typedef float f32x2_cv __attribute__((ext_vector_type(2))); typedef __bf16 bf16x2_cv __attribute__((ext_vector_type(2)));
__device__ __forceinline__ unsigned cvt_pk_bf16(float lo, float hi) { const f32x2_cv v = {lo, hi}; return __builtin_bit_cast(unsigned, __builtin_convertvector(v, bf16x2_cv)); }
typedef float f32x2 __attribute__((ext_vector_type(2)));
constexpr float RMS_EPS_C = 1e-6f;
__device__ __forceinline__ float rstd_of(float ss) { return __builtin_amdgcn_rsqf(ss * (1.0f / 1024.0f) + RMS_EPS_C); }
__device__ __forceinline__ float silu_mul(float g, float u) { return g * __builtin_amdgcn_rcpf(1.0f + __builtin_amdgcn_exp2f(g * -1.4426950408889634f)) * u; }

typedef float f32x2v __attribute__((ext_vector_type(2)));
struct EpiSwiglu {
    static constexpr bool PERM = true, AFTER_DRAIN = false;
    bf16_t* H; const float* ssq; int ldh;
    __device__ __forceinline__ void operator()(const f32x4 (&acc)[2][2][4][2], const Unit& u, int wr, int wc, int fr, int fq) const {
        const int row0 = u.pm * BM + wr * 64 + fr, col0 = u.pn * 128 + wc * 32 + 8 * fq;
        float rsv[2][4];
#pragma unroll
        for (int ai = 0; ai < 2; ++ai)
#pragma unroll
            for (int m = 0; m < 4; ++m) rsv[ai][m] = ssq[row0 + ai * HALF + m * 16];
        __builtin_amdgcn_sched_barrier(0);
#pragma unroll
        for (int ai = 0; ai < 2; ++ai)
#pragma unroll
            for (int m = 0; m < 4; ++m) {
                const int row = row0 + ai * HALF + m * 16; const float rs = rstd_of(rsv[ai][m]), k1 = rs * -1.4426950408889634f, rs2 = rs * rs;
                u32x4 w;
#pragma unroll
                for (int n = 0; n < 2; ++n)
#pragma unroll
                    for (int hp = 0; hp < 2; ++hp) {
                        const f32x2v g = (f32x2v){acc[ai][0][m][n][2 * hp], acc[ai][0][m][n][2 * hp + 1]}, uu = (f32x2v){acc[ai][1][m][n][2 * hp], acc[ai][1][m][n][2 * hp + 1]};
                        const f32x2v p = (g * uu) * rs2, a = g * k1;
                        f32x2v t; t.x = __builtin_amdgcn_exp2f(a.x); t.y = __builtin_amdgcn_exp2f(a.y);
                        const f32x2v d = t + 1.0f;
                        f32x2v r; r.x = __builtin_amdgcn_rcpf(d.x); r.y = __builtin_amdgcn_rcpf(d.y);
                        const f32x2v hv = p * r;
                        w[2 * n + hp] = cvt_pk_bf16(hv.x, hv.y);
                    }
                *(u32x4*)(H + (size_t)row * ldh + col0) = w;
            }
    }
};
typedef unsigned u32x2 __attribute__((ext_vector_type(2)));
struct EpiRes {
    static constexpr bool PERM = true, AFTER_DRAIN = false;
    bf16_t* xh; float* ssq_out; float alpha;
    __device__ __forceinline__ void load4(u32x4 (&hv)[4][2], size_t off0) const {
#pragma unroll
        for (int m = 0; m < 4; ++m)
#pragma unroll
            for (int bj = 0; bj < 2; ++bj) hv[m][bj] = *(const u32x4*)(xh + off0 + (size_t)m * 16 * 1024 + bj * HALF);
    }
    __device__ __forceinline__ float group(const f32x4 (&a)[2][4][2], int m, const u32x4 (&hv)[2], size_t off) const {
        float ss = 0.f;
#pragma unroll
        for (int bj = 0; bj < 2; ++bj) {
            float o[8];
#pragma unroll
            for (int e = 0; e < 8; ++e) {
                const unsigned hw = hv[bj][e >> 1];
                const float base = __builtin_bit_cast(float, (e & 1) ? (hw & 0xffff0000u) : (hw << 16));
                o[e] = base + a[bj][m][e >> 2][e & 3] * alpha; ss += o[e] * o[e];
            }
            u32x4 w; w.x = cvt_pk_bf16(o[0], o[1]); w.y = cvt_pk_bf16(o[2], o[3]); w.z = cvt_pk_bf16(o[4], o[5]); w.w = cvt_pk_bf16(o[6], o[7]);
            *(u32x4*)(xh + off + bj * HALF) = w;
        }
        ss += __shfl_xor(ss, 16); ss += __shfl_xor(ss, 32);
        return ss;
    }
    __device__ __forceinline__ void operator()(const f32x4 (&acc)[2][2][4][2], const Unit& u, int wr, int wc, int fr, int fq) const {
        const int row0 = u.pm * BM + wr * 64 + fr, col0 = u.pn * BM + wc * 32 + 8 * fq;
        const size_t off0 = (size_t)row0 * 1024 + col0, off1 = off0 + (size_t)HALF * 1024;
        u32x4 hA[4][2], hB[4][2];
        load4(hA, off0); load4(hB, off1);
        __builtin_amdgcn_sched_barrier(0);
        const int rbase = u.pm * BM + wr * 64 + 16 * fq + fr;
        float sa[4], sb[4];
#pragma unroll
        for (int m = 0; m < 4; ++m) sa[m] = group(acc[0], m, hA[m], off0 + (size_t)m * 16 * 1024);
        atomicAdd(ssq_out + rbase, fq == 0 ? sa[0] : fq == 1 ? sa[1] : fq == 2 ? sa[2] : sa[3]);
#pragma unroll
        for (int m = 0; m < 4; ++m) sb[m] = group(acc[1], m, hB[m], off1 + (size_t)m * 16 * 1024);
        atomicAdd(ssq_out + rbase + HALF, fq == 0 ? sb[0] : fq == 1 ? sb[1] : fq == 2 ? sb[2] : sb[3]);
    }
};
struct EpiResFinal {
    static constexpr bool PERM = true, AFTER_DRAIN = false;
    const bf16_t* xh; float* ssq_out; unsigned* cnt; const float* gain; float* out; float alpha;
    __device__ __forceinline__ void operator()(const f32x4 (&acc_c)[2][2][4][2], const Unit& u, int wr, int wc, int fr, int fq) const {
        f32x4 (&acc)[2][2][4][2] = const_cast<f32x4 (&)[2][2][4][2]>(acc_c);
        const int row0 = u.pm * BM + wr * 64 + fr, col0 = u.pn * BM + wc * 32 + 8 * fq;
        const size_t off0 = (size_t)row0 * 1024 + col0;
        u32x4 hv[2][4][2];
#pragma unroll
        for (int ai = 0; ai < 2; ++ai)
#pragma unroll
            for (int m = 0; m < 4; ++m)
#pragma unroll
                for (int bj = 0; bj < 2; ++bj) hv[ai][m][bj] = *(const u32x4*)(xh + off0 + (size_t)(ai * HALF + m * 16) * 1024 + bj * HALF);
        __builtin_amdgcn_sched_barrier(0);
#pragma unroll
        for (int ai = 0; ai < 2; ++ai) {
            float sv[4];
#pragma unroll
            for (int m = 0; m < 4; ++m) {
                float ss = 0.f;
#pragma unroll
                for (int bj = 0; bj < 2; ++bj)
#pragma unroll
                    for (int e = 0; e < 8; ++e) {
                        const unsigned hw = hv[ai][m][bj][e >> 1];
                        const float base = __builtin_bit_cast(float, (e & 1) ? (hw & 0xffff0000u) : (hw << 16));
                        const float o = base + acc[ai][bj][m][e >> 2][e & 3] * alpha; acc[ai][bj][m][e >> 2][e & 3] = o; ss += o * o;
                    }
                ss += __shfl_xor(ss, 16); ss += __shfl_xor(ss, 32);
                sv[m] = ss;
            }
            atomicAdd(ssq_out + u.pm * BM + wr * 64 + ai * HALF + 16 * fq + fr, fq == 0 ? sv[0] : fq == 1 ? sv[1] : fq == 2 ? sv[2] : sv[3]);
        }
        asm volatile("s_waitcnt vmcnt(0)" ::: "memory");
        unsigned* pc = cnt + 64 * u.pm;
        if ((threadIdx.x & 63) == 0) __hip_atomic_fetch_add(pc, 1u, __ATOMIC_RELAXED, __HIP_MEMORY_SCOPE_AGENT);
        { unsigned spins = 0;
          while ((unsigned)__builtin_amdgcn_readfirstlane(__hip_atomic_load(pc, __ATOMIC_RELAXED, __HIP_MEMORY_SCOPE_AGENT)) < 32u) { __builtin_amdgcn_s_sleep(2); if (++spins > (1u << 16)) break; } }
        float rs[2][4];
#pragma unroll
        for (int ai = 0; ai < 2; ++ai)
#pragma unroll
            for (int m = 0; m < 4; ++m) rs[ai][m] = rstd_of(__hip_atomic_load(ssq_out + row0 + ai * HALF + m * 16, __ATOMIC_RELAXED, __HIP_MEMORY_SCOPE_AGENT));
        f32x4 gv[2][2];
#pragma unroll
        for (int bj = 0; bj < 2; ++bj) { gv[bj][0] = *(const f32x4*)(gain + col0 + bj * HALF); gv[bj][1] = *(const f32x4*)(gain + col0 + bj * HALF + 4); }
#pragma unroll
        for (int ai = 0; ai < 2; ++ai)
#pragma unroll
            for (int m = 0; m < 4; ++m)
#pragma unroll
                for (int bj = 0; bj < 2; ++bj) {
                    float* op = out + off0 + (size_t)(ai * HALF + m * 16) * 1024 + bj * HALF;
                    *(f32x4*)op = acc[ai][bj][m][0] * rs[ai][m] * gv[bj][0]; *(f32x4*)(op + 4) = acc[ai][bj][m][1] * rs[ai][m] * gv[bj][1];
                }
    }
};
struct EpiZ {
    static constexpr bool PERM = true, AFTER_DRAIN = false;
    bf16_t *Q, *P; const float* ssq; size_t qk_stride;
    __device__ __forceinline__ void operator()(const f32x4 (&acc)[2][2][4][2], const Unit& u, int wr, int wc, int fr, int fq) const {
        const int row0 = u.pm * BM + wr * 64 + fr, kind = u.pn >> 1;
        float rsv[2][4];
#pragma unroll
        for (int ai = 0; ai < 2; ++ai)
#pragma unroll
            for (int m = 0; m < 4; ++m) rsv[ai][m] = ssq[row0 + ai * HALF + m * 16];
        __builtin_amdgcn_sched_barrier(0);
        if (kind == 2) {
            const int colt = (u.pn & 1) * BM + wc * 32 + 8 * fq;
#pragma unroll
            for (int ai = 0; ai < 2; ++ai)
#pragma unroll
                for (int m = 0; m < 4; ++m) {
                    const int row = row0 + ai * HALF + m * 16; const float rs = rstd_of(rsv[ai][m]);
#pragma unroll
                    for (int bj = 0; bj < 2; ++bj) {
                        const f32x4 v0 = acc[ai][bj][m][0] * rs, v1 = acc[ai][bj][m][1] * rs;
                        u32x4 w; w.x = cvt_pk_bf16(v0[0], v0[1]); w.y = cvt_pk_bf16(v0[2], v0[3]); w.z = cvt_pk_bf16(v1[0], v1[1]); w.w = cvt_pk_bf16(v1[2], v1[3]);
                        *(u32x4*)(P + (size_t)row * 512 + colt + bj * HALF) = w;
                    }
                }
        } else {
            bf16_t* dst = Q + (size_t)kind * qk_stride; const float sc = kind == 0 ? 0.125f * 1.4426950408889634f : 1.0f;
            const int b = u.pm >> 3, h0 = 4 * (u.pn & 1) + (wc >> 1), ks = wc & 1;
#pragma unroll
            for (int ai = 0; ai < 2; ++ai)
#pragma unroll
                for (int m = 0; m < 4; ++m) {
                    const float rs = rstd_of(rsv[ai][m]) * sc;
                    const int grow = (u.pm & 7) * 4 + 2 * ai + wr, col = 16 * m + fr;
#pragma unroll
                    for (int bj = 0; bj < 2; ++bj) {
                        const f32x4 v0 = acc[ai][bj][m][0] * rs, v1 = acc[ai][bj][m][1] * rs;
                        u32x4 w; w.x = cvt_pk_bf16(v0[0], v0[1]); w.y = cvt_pk_bf16(v0[2], v0[3]); w.z = cvt_pk_bf16(v1[0], v1[1]); w.w = cvt_pk_bf16(v1[2], v1[3]);
                        const size_t idx = ((((size_t)((b * 8 + h0 + 2 * bj) * 32 + grow) * 2 + ks) * 4 + fq) * 64 + col) * 8;
                        *(u32x4*)(dst + idx) = w;
                    }
                }
        }
    }
};
struct EpiVT {
    static constexpr bool PERM = true, AFTER_DRAIN = false;
    bf16_t* VF; const float* ssq;
    __device__ __forceinline__ void operator()(const f32x4 (&acc)[2][2][4][2], const Unit& u, int wr, int wc, int fr, int fq) const {
        typedef unsigned u32x2 __attribute__((ext_vector_type(2)));
        const int b = u.pn >> 3, tok0 = u.pn * BM + wc * 32 + 8 * fq;
        f32x4 sqv[2][2];
#pragma unroll
        for (int bj = 0; bj < 2; ++bj)
#pragma unroll
            for (int n = 0; n < 2; ++n) sqv[bj][n] = *(const f32x4*)(ssq + tok0 + bj * HALF + 4 * n);
        __builtin_amdgcn_sched_barrier(0);
#pragma unroll
        for (int bj = 0; bj < 2; ++bj)
#pragma unroll
            for (int n = 0; n < 2; ++n) {
                const f32x4 sq = sqv[bj][n];
                const f32x4 rs = (f32x4){rstd_of(sq[0]), rstd_of(sq[1]), rstd_of(sq[2]), rstd_of(sq[3])};
                const int grow = (u.pn & 7) * 4 + 2 * bj + (wc >> 1), cg = (wc & 1) * 8 + 2 * fq + n;
#pragma unroll
                for (int ai = 0; ai < 2; ++ai)
#pragma unroll
                    for (int m = 0; m < 4; ++m) {
                        const int h = 4 * u.pm + 2 * ai + wr;
                        const f32x4 v = acc[ai][bj][m][n] * rs;
                        u32x2 w; w.x = cvt_pk_bf16(v[0], v[1]); w.y = cvt_pk_bf16(v[2], v[3]);
                        *(u32x2*)(VF + ((((size_t)((b * 8 + h) * 32 + grow) * 16 + cg) * 64 + ((m ^ n) * 16 + fr)) * 4)) = w;
                    }
            }
    }
};

struct EpiNull {
    static constexpr bool PERM = true, AFTER_DRAIN = false;
    float* out;
    __device__ __forceinline__ void operator()(const f32x4 (&acc)[2][2][4][2], const Unit& u, int wr, int wc, int fr, int fq) const {
        float s = 0.f;
#pragma unroll
        for (int ai = 0; ai < 2; ++ai)
#pragma unroll
            for (int bj = 0; bj < 2; ++bj)
#pragma unroll
                for (int m = 0; m < 4; ++m)
#pragma unroll
                    for (int n = 0; n < 2; ++n) s += acc[ai][bj][m][n][0] + acc[ai][bj][m][n][1] + acc[ai][bj][m][n][2] + acc[ai][bj][m][n][3];
        if (s == 1.2345e38f) out[u.pm] = s;
    }
};

struct WinOrder {
    StaticOrder z, v; int nzc;
    __device__ void init(int M, int G, int c) { z.init(M, 1536, G, c); v.init(512, M, G, c); nzc = (z.nwg - c + G - 1) / G; if (nzc < 0) nzc = 0; }
    __device__ bool next(int i, Unit& u) const {
        if (i < nzc) return z.next(i, u);
        if (!v.next(i - nzc, u)) return false;
        u.pm += 6; u.swp = 1; return true;
    }
    __device__ __forceinline__ void a_ready(const Unit&) const {}
    __device__ __forceinline__ void done(const Unit&) const {}
};
struct EpiZV {
    static constexpr bool PERM = true, AFTER_DRAIN = false;
    EpiZ ez; EpiVT ev;
    __device__ __forceinline__ void operator()(const f32x4 (&acc)[2][2][4][2], const Unit& u, int wr, int wc, int fr, int fq) const {
        if (u.swp) { Unit uv; uv.pm = u.pm - 6; uv.pn = u.pn; uv.swp = 1; ev(acc, uv, wr, wc, fr, fq); } else ez(acc, u, wr, wc, fr, fq);
    }
};
template <class Epi, class Sched, bool ALIGN_EPI = false, bool SP2 = false>
__device__ __forceinline__ void gemm_phase(PG8_LAS unsigned char* lds, const Gemm g, const Sched& S, const Epi& E) {
    int tid_ = threadIdx.x; asm volatile("" : "+v"(tid_));
    const int tid = tid_, wid = __builtin_amdgcn_readfirstlane(tid >> 6), lane = tid & 63, wr = wid >> 2, wc = wid & 3, fr = lane & 15, fq = lane >> 4;
    const int K = g.K, nt = K / BK;
    unsigned voffA[2], voffB[2];
#pragma unroll
    for (int i = 0; i < 2; ++i) { int R, C; stage_rc(tid * 16 + i * 8192, R, C); const int Rb = Epi::PERM ? ((R & ~31) + perm32(R & 31)) : R;
        voffA[i] = (unsigned)(R * K + C) * 2u; voffB[i] = (unsigned)(Rb * K + C) * 2u; }
    const size_t kstep = (size_t)(BK * 2);
    const size_t hstep = (size_t)HALF * K * 2;
    const size_t tstep = 2 * hstep;
    const unsigned ldsw = (unsigned)wid * 1024u;
    const int aoff = lds_byte(wr * 64 + fr, fq * 8), boff = lds_byte(wc * 32 + fr, fq * 8);
#define PG8_SA(b, h) (((b) * 2 + (h)) * HTB)
#define PG8_SB(b, h) ((4 + (b) * 2 + (h)) * HTB)
#define PG8_STAGE(bufoff, gbase, voff) do { _Pragma("unroll") for (int _i = 0; _i < 2; ++_i) \
        __builtin_amdgcn_global_load_lds((const unsigned*)((const char*)(gbase) + (voff)[_i]), (PG8_LAS unsigned*)(lds + (bufoff) + ldsw + _i * 8192), 16, 0, 0); } while (0)
#define PG8_LDA(dst, b, h) do { _Pragma("unroll") for (int m = 0; m < 4; ++m) _Pragma("unroll") for (int k = 0; k < 2; ++k) dst[m][k] = *(const PG8_LAS bf16x8*)(lds + PG8_SA(b, h) + aoff + m * 2048 + k * 1024); } while (0)
#define PG8_LDB(dst, b, h) do { _Pragma("unroll") for (int n = 0; n < 2; ++n) _Pragma("unroll") for (int k = 0; k < 2; ++k) dst[n][k] = *(const PG8_LAS bf16x8*)(lds + PG8_SB(b, h) + boff + n * 2048 + k * 1024); } while (0)
#define PG8_MMA(ai, bj, At, Bt) do { __builtin_amdgcn_s_setprio(1); _Pragma("unroll") for (int m = 0; m < 4; ++m) _Pragma("unroll") for (int n = 0; n < 2; ++n) _Pragma("unroll") for (int k = 0; k < 2; ++k) \
        acc[ai][bj][m][n] = __builtin_amdgcn_mfma_f32_16x16x32_bf16(Bt[n][k], At[m][k], acc[ai][bj][m][n], 0, 0, 0); __builtin_amdgcn_s_setprio(0); } while (0)
#define PG8_WAIT_V(n) asm volatile("s_waitcnt vmcnt(" #n ")" ::: "memory")
#define PG8_WAIT_L(n) asm volatile("s_waitcnt lgkmcnt(" #n ")" ::: "memory")
#define PG8_BAR __builtin_amdgcn_s_barrier()
#define PG8_SCHED __builtin_amdgcn_sched_barrier(0)
    Unit cur, nxt; int ui = 0;
    if (!S.next(0, cur)) return;
    f32x4 acc[2][2][4][2];
#pragma unroll
    for (int a = 0; a < 2; ++a)
#pragma unroll
        for (int b = 0; b < 2; ++b)
#pragma unroll
            for (int m = 0; m < 4; ++m)
#pragma unroll
                for (int n = 0; n < 2; ++n) acc[a][b][m][n] = (f32x4){0.f, 0.f, 0.f, 0.f};
    bf16x8 At[4][2], B0[2][2], B1[2][2];
    const char* cA = (const char*)(cur.swp ? g.Bt : g.A) + (size_t)cur.pm * tstep; const char* cB = (const char*)(cur.swp ? g.A : g.Bt) + (size_t)cur.pn * tstep;
    S.a_ready(cur);
    if constexpr (SP2) {
        PG8_STAGE(PG8_SB(0, 0), cB, voffB); PG8_STAGE(PG8_SB(0, 1), cB + hstep, voffB); PG8_STAGE(PG8_SA(0, 0), cA, voffA); PG8_STAGE(PG8_SA(0, 1), cA + hstep, voffA);
        if (wr == 1) PG8_BAR;
        PG8_WAIT_V(2); PG8_BAR;
        PG8_STAGE(PG8_SB(1, 0), cB + kstep, voffB); PG8_STAGE(PG8_SA(1, 0), cA + kstep, voffA); PG8_STAGE(PG8_SB(1, 1), cB + hstep + kstep, voffB);
        PG8_WAIT_V(6); PG8_BAR;
    } else {
        PG8_STAGE(PG8_SB(0, 0), cB, voffB); PG8_STAGE(PG8_SA(0, 0), cA, voffA); PG8_STAGE(PG8_SB(0, 1), cB + hstep, voffB); PG8_STAGE(PG8_SA(0, 1), cA + hstep, voffA);
        if (wr == 1) PG8_BAR;
        PG8_WAIT_V(4); PG8_BAR;
        PG8_STAGE(PG8_SB(1, 0), cB + kstep, voffB); PG8_STAGE(PG8_SA(1, 0), cA + kstep, voffA); PG8_STAGE(PG8_SB(1, 1), cB + hstep + kstep, voffB);
        PG8_WAIT_V(6); PG8_BAR;
    }
    for (;;) {
        const bool has_next = S.next(ui + 1, nxt);
        const char* nA = has_next ? (const char*)(nxt.swp ? g.Bt : g.A) + (size_t)nxt.pm * tstep : cA; const char* nB = has_next ? (const char*)(nxt.swp ? g.A : g.Bt) + (size_t)nxt.pn * tstep : cB;
        for (int t = 0; t < nt; t += 2) {
            const bool last = (t == nt - 2);
            const char* a1 = cA + (size_t)(t + 1) * kstep;
            const char* a2 = last ? nA : cA + (size_t)(t + 2) * kstep; const char* b2 = last ? nB : cB + (size_t)(t + 2) * kstep;
            const char* a3 = a2 + kstep; const char* b3 = b2 + kstep;
            if (last && has_next) S.a_ready(nxt);
            if constexpr (SP2) {
            PG8_LDB(B0, 0, 0); PG8_LDB(B1, 0, 1); PG8_SCHED; PG8_LDA(At, 0, 0); PG8_STAGE(PG8_SA(1, 1), a1 + hstep, voffA);
            PG8_WAIT_V(8); PG8_WAIT_L(0); PG8_BAR; PG8_MMA(0, 0, At, B0); PG8_MMA(0, 1, At, B1); PG8_BAR; PG8_SCHED;
            PG8_LDA(At, 0, 1); PG8_STAGE(PG8_SB(0, 0), b2, voffB); PG8_STAGE(PG8_SB(0, 1), b2 + hstep, voffB); PG8_STAGE(PG8_SA(0, 0), a2, voffA);
            PG8_WAIT_V(8); PG8_WAIT_L(0); PG8_BAR; PG8_MMA(1, 0, At, B0); PG8_MMA(1, 1, At, B1); PG8_BAR; PG8_SCHED;
            PG8_LDB(B0, 1, 0); PG8_LDB(B1, 1, 1); PG8_SCHED; PG8_LDA(At, 1, 0); PG8_STAGE(PG8_SA(0, 1), a2 + hstep, voffA);
            PG8_WAIT_V(8); PG8_WAIT_L(0); PG8_BAR; PG8_MMA(0, 0, At, B0); PG8_MMA(0, 1, At, B1); PG8_BAR; PG8_SCHED;
            PG8_LDA(At, 1, 1); PG8_STAGE(PG8_SB(1, 0), b3, voffB); PG8_STAGE(PG8_SB(1, 1), b3 + hstep, voffB); PG8_STAGE(PG8_SA(1, 0), a3, voffA);
            PG8_WAIT_V(8); PG8_WAIT_L(0); PG8_BAR; PG8_MMA(1, 0, At, B0); PG8_MMA(1, 1, At, B1); PG8_BAR; PG8_SCHED;
            } else {
            PG8_LDB(B0, 0, 0); PG8_SCHED; PG8_LDA(At, 0, 0); PG8_STAGE(PG8_SA(1, 1), a1 + hstep, voffA);
            PG8_WAIT_L(8); PG8_BAR; PG8_WAIT_L(0); PG8_MMA(0, 0, At, B0); PG8_BAR; PG8_SCHED;
            PG8_LDB(B1, 0, 1); PG8_STAGE(PG8_SB(0, 0), b2, voffB);
            PG8_BAR; PG8_WAIT_L(0); PG8_MMA(0, 1, At, B1); PG8_BAR;
            PG8_LDA(At, 0, 1); PG8_STAGE(PG8_SA(0, 0), a2, voffA);
            PG8_BAR; PG8_WAIT_L(0); PG8_MMA(1, 0, At, B0); PG8_BAR; PG8_SCHED;
            PG8_STAGE(PG8_SB(0, 1), b2 + hstep, voffB);
            PG8_WAIT_V(6); PG8_BAR; PG8_MMA(1, 1, At, B1); PG8_BAR;
            PG8_LDB(B0, 1, 0); PG8_SCHED; PG8_LDA(At, 1, 0); PG8_STAGE(PG8_SA(0, 1), a2 + hstep, voffA);
            PG8_WAIT_L(8); PG8_BAR; PG8_WAIT_L(0); PG8_MMA(0, 0, At, B0); PG8_BAR; PG8_SCHED;
            PG8_LDB(B1, 1, 1); PG8_STAGE(PG8_SB(1, 0), b3, voffB);
            PG8_BAR; PG8_WAIT_L(0); PG8_MMA(0, 1, At, B1); PG8_BAR;
            PG8_LDA(At, 1, 1); PG8_STAGE(PG8_SA(1, 0), a3, voffA);
            PG8_BAR; PG8_WAIT_L(0); PG8_MMA(1, 0, At, B0); PG8_BAR; PG8_SCHED;
            PG8_STAGE(PG8_SB(1, 1), b3 + hstep, voffB);
            PG8_WAIT_V(6); PG8_BAR; PG8_MMA(1, 1, At, B1); PG8_BAR;
            }
        }
        if constexpr (ALIGN_EPI) { if (wr == 0) PG8_BAR; }
        if constexpr (!Epi::AFTER_DRAIN) { E(acc, cur, wr, wc, fr, fq); S.done(cur); }
        if (!has_next) break;
#pragma unroll
        for (int a = 0; a < 2; ++a)
#pragma unroll
            for (int b = 0; b < 2; ++b)
#pragma unroll
                for (int m = 0; m < 4; ++m)
#pragma unroll
                    for (int n = 0; n < 2; ++n) acc[a][b][m][n] = (f32x4){0.f, 0.f, 0.f, 0.f};
        cur = nxt; cA = nA; cB = nB; ++ui;
        if constexpr (ALIGN_EPI) { if (wr == 1) PG8_BAR; }
    }
    PG8_WAIT_V(0);
    if constexpr (!ALIGN_EPI) { if (wr == 0) PG8_BAR; }
    PG8_BAR;
    if constexpr (Epi::AFTER_DRAIN) { E.fused(acc, cur, wr, wc, fr, fq, lds, wid, lane); S.done(cur); }
#undef PG8_SA
#undef PG8_SB
#undef PG8_STAGE
#undef PG8_LDA
#undef PG8_LDB
#undef PG8_MMA
#undef PG8_WAIT_V
#undef PG8_WAIT_L
#undef PG8_BAR
#undef PG8_SCHED
}
}
constexpr int NB = 16, SEQ = 2048, D = 1024, M = NB * SEQ, FF = 2816, NIN = 2048, DEPTH = 2;
constexpr int NWAVES = 8;
constexpr size_t MiB = 1u << 20;
constexpr size_t WS_PCNT = 1 * MiB + 64 * 1024;
constexpr size_t WS_BAR = 1 * MiB;
constexpr size_t WS_SSQ = 0;
constexpr size_t WS_W = 2 * MiB, W_LAYER = 39 * MiB;
constexpr size_t WO_GU1 = 0, WO_D1 = 11 * MiB, WO_IN = 16 * MiB + MiB / 2, WO_OUT = 20 * MiB + MiB / 2, WO_GU2 = 22 * MiB + MiB / 2, WO_D2 = 33 * MiB + MiB / 2;
constexpr size_t WS_XB = 80 * MiB;
constexpr size_t WS_H = 144 * MiB;
constexpr size_t WS_Q = 144 * MiB, WS_K = 176 * MiB, WS_P = 208 * MiB, WS_VT = 240 * MiB, WS_CAT = 272 * MiB, WS_XL = 336 * MiB, WS_END = 368 * MiB;
static_assert(WS_K - WS_Q == WS_P - WS_K && WS_H + (size_t)M * FF * 2 <= WS_END && WS_W + 2 * W_LAYER <= WS_XB, "d_ws map");
constexpr int LDS_BYTES = 150272;
constexpr int MISC_OFF = 150016;

#define GAS __attribute__((address_space(1)))
#define LAS __attribute__((address_space(3)))
typedef unsigned short bf16;
typedef unsigned v4u __attribute__((ext_vector_type(4)));
typedef unsigned v2u __attribute__((ext_vector_type(2)));
typedef float f32x4 __attribute__((ext_vector_type(4)));
typedef short bf16x8 __attribute__((ext_vector_type(8)));
#define LDS_WAIT() asm volatile("s_waitcnt lgkmcnt(0)" ::: "memory")
__device__ __forceinline__ unsigned f2bf(float f) { unsigned u = __builtin_bit_cast(unsigned, f); return (u + 0x7fffu + ((u >> 16) & 1u)) >> 16; }
typedef float f32x2_pk __attribute__((ext_vector_type(2))); typedef __bf16 bf16x2_pk __attribute__((ext_vector_type(2)));
__device__ __forceinline__ unsigned pk2(float lo, float hi) { const f32x2_pk v = {lo, hi}; return __builtin_bit_cast(unsigned, __builtin_convertvector(v, bf16x2_pk)); }
__device__ __forceinline__ float bflo(unsigned w) { return __builtin_bit_cast(float, w << 16); }
__device__ __forceinline__ float bfhi(unsigned w) { return __builtin_bit_cast(float, w & 0xffff0000u); }
__device__ __forceinline__ float wave_sum(float v) {
#pragma unroll
    for (int o = 1; o < 64; o <<= 1) v += __shfl_xor(v, o);
    return v;
}

#define XB_TMO      128
#define XB_XCNT(j)  (256  + 64 * (j))
#define XB_XSUB(j)  (1280 + 64 * (j))
#define XB_XGEN(j)  (2304 + 64 * (j))
#define XB_TOP      3328
#define XB_TOPGEN   3392
#define XCD_BAR_WORDS 3456
#define XB_SPIN_CAP (1u << 18)

__device__ __forceinline__ unsigned xb_ld(unsigned* p)              { return __hip_atomic_load(p, __ATOMIC_RELAXED, __HIP_MEMORY_SCOPE_AGENT); }
__device__ __forceinline__ unsigned xb_add(unsigned* p, unsigned v) { return __hip_atomic_fetch_add(p, v, __ATOMIC_RELAXED, __HIP_MEMORY_SCOPE_AGENT); }
__device__ __forceinline__ unsigned xb_xcc_id() { return (unsigned)__builtin_amdgcn_s_getreg((3 << 11) | 20) & 0xFu; }
#define XB_SPIN(cond, bar) do { unsigned _sp = 0; while (cond) { __builtin_amdgcn_s_sleep(1); \
    if ((++_sp & 255u) == 0u) { if (xb_ld(&(bar)[XB_TMO])) break; if (_sp > XB_SPIN_CAP) { atomicAdd(&(bar)[XB_TMO], 1u); break; } } } } while (0)

struct XcdBarrier {
    unsigned* bar; unsigned x;
    volatile LAS unsigned* st;
};

__device__ __forceinline__ XcdBarrier xcd_barrier_post(unsigned* bar, volatile LAS unsigned* st) {
    XcdBarrier b; b.bar = bar; b.x = xb_xcc_id(); b.st = st;
    if (threadIdx.x == 0) (void)xb_add(&bar[XB_XCNT(b.x)], 1u);
    return b;
}
__device__ __forceinline__ void xcd_barrier_complete(unsigned* bar, unsigned x, unsigned& nloc, unsigned& nx) {
    const unsigned G = gridDim.x * gridDim.y * gridDim.z;
    unsigned sum, cnt, mine, sp = 0u;
    for (;;) {
        sum = 0u; cnt = 0u; mine = 0u;
#pragma unroll
        for (unsigned j = 0; j < 16; ++j) { const unsigned c = xb_ld(&bar[XB_XCNT(j)]); sum += c; cnt += (c > 0u) ? 1u : 0u; mine = (j == x) ? c : mine; }
        if (sum == G) break;
        __builtin_amdgcn_s_sleep(1);
        if ((++sp & 255u) == 0u) { if (xb_ld(&bar[XB_TMO])) break; if (sp > XB_SPIN_CAP) { atomicAdd(&bar[XB_TMO], 1u); break; } }
    }
    nloc = mine > 0u ? mine : 1u; nx = cnt > 0u ? cnt : 1u;
}

__device__ __forceinline__ void xcd_barrier(const XcdBarrier& b) {
    asm volatile("s_waitcnt vmcnt(0)" ::: "memory");
    __syncthreads();
    if (threadIdx.x == 0) {
        unsigned* bar = b.bar;
        __builtin_amdgcn_s_waitcnt(0);
        unsigned nloc = b.st[0], nx = b.st[1];
        if (nloc == 0u) { xcd_barrier_complete(bar, b.x, nloc, nx); b.st[0] = nloc; b.st[1] = nx; }
        const unsigned old = xb_add(&bar[XB_XSUB(b.x)], 1u);
        const unsigned gen = old / nloc;
        if (old + 1u == (gen + 1u) * nloc) {
            __builtin_amdgcn_fence(__ATOMIC_RELEASE, "agent");
            asm volatile("s_waitcnt vmcnt(0)" ::: "memory");
            const unsigned og = xb_add(&bar[XB_TOP], 1u);
            const unsigned tg = og / nx;
            if (og + 1u == (tg + 1u) * nx) xb_add(&bar[XB_TOPGEN], 1u);
            else XB_SPIN(xb_ld(&bar[XB_TOPGEN]) == tg, bar);
            __builtin_amdgcn_fence(__ATOMIC_ACQUIRE, "agent");
            xb_add(&bar[XB_XGEN(b.x)], 1u);
            asm volatile("s_waitcnt vmcnt(0)" ::: "memory");
        } else {
            XB_SPIN(xb_ld(&bar[XB_XGEN(b.x)]) == gen, bar);
            __builtin_amdgcn_fence(__ATOMIC_ACQUIRE, "agent");
            asm volatile("s_waitcnt vmcnt(0)" ::: "memory");
        }
    }
    __syncthreads();
}

typedef float f32x2 __attribute__((ext_vector_type(2)));
__device__ __forceinline__ void transpose_item(const float* W, int ldw, const float* gain, bf16* WT, int ldt, int k0, int n0, int drow0, int lane) {
    const float* src = W + (size_t)k0 * ldw + n0 + 2 * lane;
    bf16* d0 = WT + (size_t)(drow0 + 2 * lane) * ldt + k0;
    f32x2 v[64];
#pragma unroll
    for (int kk = 0; kk < 64; ++kk) v[kk] = *(const f32x2*)(src + (size_t)kk * ldw);
    const float gl = gain ? gain[k0 + lane] : 1.0f;
#pragma unroll
    for (int col = 0; col < 2; ++col) {
#pragma unroll
        for (int c = 0; c < 8; ++c) {
            float e[8];
#pragma unroll
            for (int kk = 0; kk < 8; ++kk) { const float gk = __builtin_bit_cast(float, __builtin_amdgcn_readlane(__builtin_bit_cast(int, gl), 8 * c + kk)); e[kk] = (col ? v[8 * c + kk].y : v[8 * c + kk].x) * gk; }
            v4u o; o.x = pk2(e[0], e[1]); o.y = pk2(e[2], e[3]); o.z = pk2(e[4], e[5]); o.w = pk2(e[6], e[7]);
            *(v4u*)(d0 + (size_t)col * ldt + 8 * c) = o;
        }
    }
}
struct LayerW { const float *n1, *g1, *u1, *d1, *nm, *win, *rpb, *wpool, *pscale, *wout, *n2, *g2, *u2, *d2; bf16 *GU1, *D1, *WIN, *WOUT, *GU2, *D2; };
__device__ __forceinline__ LayerW layer_w(const float* const* in, unsigned char* ws, int l) {
    LayerW w;
    w.n1 = in[1] + (size_t)l * D; w.g1 = in[2] + (size_t)l * D * FF; w.u1 = in[3] + (size_t)l * D * FF; w.d1 = in[4] + (size_t)l * FF * D;
    w.nm = in[5] + (size_t)l * D; w.win = in[6] + (size_t)l * D * NIN; w.rpb = in[7] + (size_t)l * 8 * 15 * 31; w.wpool = in[8] + (size_t)l * 4 * 128 * 128;
    w.pscale = in[9] + (size_t)l * 512; w.wout = in[10] + (size_t)l * D * D; w.n2 = in[11] + (size_t)l * D;
    w.g2 = in[12] + (size_t)l * D * FF; w.u2 = in[13] + (size_t)l * D * FF; w.d2 = in[14] + (size_t)l * FF * D;
    unsigned char* b = ws + WS_W + (size_t)l * W_LAYER;
    w.GU1 = (bf16*)(b + WO_GU1); w.D1 = (bf16*)(b + WO_D1); w.WIN = (bf16*)(b + WO_IN); w.WOUT = (bf16*)(b + WO_OUT); w.GU2 = (bf16*)(b + WO_GU2); w.D2 = (bf16*)(b + WO_D2);
    return w;
}
__device__ __forceinline__ void prologue(const float* const* in, unsigned char* ws, int gw, int NGW, int lane, int part) {
    constexpr int I_GU = (D / 64) * (FF / 128), I_DN = (FF / 64) * (D / 128), I_IN = (D / 64) * (NIN / 128), I_OUT = (512 / 64) * (D / 128), I_FOLD = 4 * 16 * 16;
    constexpr int I_LAYER = 4 * I_GU + 2 * I_DN + I_IN + I_OUT + I_FOLD;
    if (part & 1)
    for (int it = gw; it < DEPTH * I_LAYER; it += NGW) {
        const int l = it / I_LAYER; int r = it % I_LAYER; const LayerW w = layer_w(in, ws, l);
        if (r < 4 * I_GU) {
            const int which = r / I_GU; r %= I_GU; const int nkb = D / 64, kb = r % nkb, nb = r / nkb;
            const float* W = which == 0 ? w.g1 : which == 1 ? w.u1 : which == 2 ? w.g2 : w.u2; const float* gn = which < 2 ? w.n1 : w.n2; bf16* T = which < 2 ? w.GU1 : w.GU2;
            transpose_item(W, FF, gn, T, D, 64 * kb, 128 * nb, nb * 256 + (which & 1) * 128, lane); continue; }
        r -= 4 * I_GU;
        if (r < 2 * I_DN) { const int which = r / I_DN; r %= I_DN; const int nkb = FF / 64, kb = r % nkb, nb = r / nkb;
            transpose_item(which ? w.d2 : w.d1, D, nullptr, which ? w.D2 : w.D1, FF, 64 * kb, 128 * nb, 128 * nb, lane); continue; }
        r -= 2 * I_DN;
        if (r < I_IN) { const int nkb = D / 64, kb = r % nkb, nb = r / nkb; const int n0 = 128 * nb; transpose_item(w.win, NIN, w.nm, w.WIN, D, 64 * kb, n0, n0 < 1024 ? n0 : (n0 < 1536 ? n0 + 512 : n0 - 512), lane); continue; }
        r -= I_IN;
        if (r < I_OUT) { const int nkb = 512 / 64, kb = r % nkb, nb = r / nkb; transpose_item(w.wout, D, nullptr, w.WOUT, D, 64 * kb, 128 * nb, 128 * nb, lane); continue; }
        r -= I_OUT;
        {
            const int g = r >> 8, nb = (r >> 4) & 15, cb = r & 15, n = 64 * nb + lane;
            const float* wp = w.wpool + ((size_t)g * 128 + 8 * cb) * 128; const float* sc = w.pscale + 128 * g; const float* wo = w.wout + (size_t)(512 + 128 * g) * D + n;
            float wr_[8][2], sr_[2];
#pragma unroll
            for (int hh = 0; hh < 2; ++hh) { sr_[hh] = sc[64 * hh + lane];
#pragma unroll
                for (int c = 0; c < 8; ++c) wr_[c][hh] = wp[c * 128 + 64 * hh + lane]; }
#pragma unroll
            for (int hh = 0; hh < 2; ++hh)
#pragma unroll
                for (int c = 0; c < 8; ++c) wr_[c][hh] *= sr_[hh];
            float a[8];
#pragma unroll
            for (int c = 0; c < 8; ++c) a[c] = 0.f;
#pragma unroll
            for (int hh = 0; hh < 2; ++hh)
#pragma unroll
                for (int q = 0; q < 2; ++q) {
                    float x[32];
#pragma unroll
                    for (int dd = 0; dd < 32; ++dd) x[dd] = wo[(size_t)(64 * hh + 32 * q + dd) * D];
#pragma unroll
                    for (int dd = 0; dd < 32; ++dd)
#pragma unroll
                        for (int c = 0; c < 8; ++c) a[c] += __builtin_bit_cast(float, __builtin_amdgcn_readlane(__builtin_bit_cast(int, wr_[c][hh]), 32 * q + dd)) * x[dd];
                }
            v4u o; o.x = pk2(a[0], a[1]); o.y = pk2(a[2], a[3]); o.z = pk2(a[4], a[5]); o.w = pk2(a[6], a[7]);
            *(v4u*)(w.WOUT + (size_t)n * D + 512 + 128 * g + 8 * cb) = o;
        }
    }
    if (!(part & 2)) return;
    const float* x = in[0]; bf16* XB = (bf16*)(ws + WS_XB); unsigned char* XL = ws + WS_XL; float* ssq = (float*)(ws + WS_SSQ);
    for (int m = gw; m < M; m += NGW) {
        const f32x4* xr = (const f32x4*)(x + (size_t)m * D) + lane; f32x4 v[4]; float s = 0.f;
#pragma unroll
        for (int j = 0; j < 4; ++j) { v[j] = xr[64 * j]; s += (v[j].x * v[j].x + v[j].y * v[j].y) + (v[j].z * v[j].z + v[j].w * v[j].w); }
        s = wave_sum(s);
        v2u* o8 = (v2u*)(XB + (size_t)m * D) + lane;
#pragma unroll
        for (int j = 0; j < 4; ++j) { v2u o; o.x = pk2(v[j].x, v[j].y); o.y = pk2(v[j].z, v[j].w); o8[64 * j] = o; }
        if (lane == 0) ssq[m] = s;
    }
    for (int i = gw * 64 + lane; i < 6 * M; i += NGW * 64) ssq[M + i] = 0.f;
    { unsigned* pc = (unsigned*)(ws + WS_PCNT); for (int i = gw * 64 + lane; i < 128 * 64; i += NGW * 64) pc[i] = 0u; }
}

__device__ __forceinline__ void acc8(float (&s)[8], const v4u v, const float sg) {
    s[0] += sg * bflo(v.x); s[1] += sg * bfhi(v.x); s[2] += sg * bflo(v.y); s[3] += sg * bfhi(v.y); s[4] += sg * bflo(v.z); s[5] += sg * bfhi(v.z); s[6] += sg * bflo(v.w); s[7] += sg * bfhi(v.w);
}
template <int W2> __device__ __forceinline__ void pool_block(const bf16* P, bf16* CAT, int tb, int g, int lane) {
    constexpr int W = 2 * W2, R = W + 15;
    const int q = lane >> 4, c8 = 8 * (lane & 15), row0 = 64 * tb + 16 * q, t0 = row0 & (SEQ - 1);
    const bf16* pb = P + (size_t)(row0 - t0) * 512 + g * 128 + c8;
    v4u r[R];
#pragma unroll
    for (int k = 0; k < R; ++k) { const int t = t0 - W2 + k, tc = min(max(t, 0), SEQ - 1);
        v4u v = *(const v4u*)(pb + (size_t)tc * 512);
        r[k] = v; }
    __builtin_amdgcn_sched_barrier(0);
#pragma unroll
    for (int k = 0; k < R; ++k) { const int t = t0 - W2 + k; if (t < 0 || t >= SEQ) r[k] = (v4u){0u, 0u, 0u, 0u}; }
    float s[8];
#pragma unroll
    for (int e = 0; e < 8; ++e) s[e] = 0.f;
#pragma unroll
    for (int k = 0; k < W; ++k) acc8(s, r[k], 1.0f);
    bf16* ob = CAT + (size_t)row0 * 1024 + 512 + g * 128 + c8;
#pragma unroll
    for (int i = 0; i < 16; ++i) {
        const int t = t0 + i, cnt = min(t + W2, SEQ) - max(t - W2, 0); const float ic = __builtin_amdgcn_rcpf((float)cnt); const v4u cv = r[i + W2];
        v4u o; o.x = pg8::cvt_pk_bf16(s[0] * ic - bflo(cv.x), s[1] * ic - bfhi(cv.x)); o.y = pg8::cvt_pk_bf16(s[2] * ic - bflo(cv.y), s[3] * ic - bfhi(cv.y));
        o.z = pg8::cvt_pk_bf16(s[4] * ic - bflo(cv.z), s[5] * ic - bfhi(cv.z)); o.w = pg8::cvt_pk_bf16(s[6] * ic - bflo(cv.w), s[7] * ic - bfhi(cv.w));
        *(v4u*)(ob + (size_t)i * 1024) = o;
        if (i < 15) { acc8(s, r[i + W], 1.0f); acc8(s, r[i], -1.0f); }
    }
}
constexpr int AT_SLOT = 16384, AT_NSLOT = 9, AT_TBL_OFF = AT_NSLOT * AT_SLOT + 256;
__device__ __forceinline__ int at_rs(int r) { return min(max(r - 4, 0), 24); }
__device__ __forceinline__ void attn_pool_phase(LAS unsigned char* lds, const bf16* Q, const bf16* K, const bf16* VT, const bf16* P, bf16* CAT, const float* rpb,
                                                int vcu, int G, int wave, int lane, int tid, int probe_mask = 3) {
    LAS float* tbl = (LAS float*)(lds + AT_TBL_OFF);
    const int j = wave & 3, rsub = wave >> 2, ql = lane & 15, quad = lane >> 4;
    const int c = 16 * j + ql, cs = min(max(c - 8, 0), 48), kc0 = min(max(16 * j - 8, 0), 32);
    const int dcb = kc0 + 4 * quad - c + 15;
    bool sel1[4];
#pragma unroll
    for (int i = 0; i < 4; ++i) sel1[i] = (4 * quad + i) < (cs - kc0);
    const int koff = (quad * 64 + kc0 + ql) * 16;
    const int voff = 8192 + ((kc0 >> 2) + quad) * 512 + ql * 8;
    if (probe_mask & 1)
    for (int wi = vcu; wi < 256; wi += G) {
        const int b = wi >> 4, g = wi & 15, h = g >> 1, half = g & 1, r0 = 16 * half;
        const size_t rowblk0 = (size_t)(b * 8 + h) * 32;
        __syncthreads();
        int cur_hi = at_rs(r0 + 1) + 7;
        {
            const int lo = at_rs(r0);
            v4u t[9][2];
#pragma unroll
            for (int q = 0; q < 9; ++q) { const int rw = min(lo + q, cur_hi);
                t[q][0] = *(const v4u*)(K + (rowblk0 + rw) * 4096 + tid * 8); t[q][1] = *(const v4u*)(VT + (rowblk0 + rw) * 4096 + tid * 8); }
            const float tv = tid < 465 ? rpb[h * 465 + tid] : 0.f;
            __builtin_amdgcn_sched_barrier(0);
            if (tid < 465) tbl[tid] = tv * 1.4426950408889634f;
#pragma unroll
            for (int q = 0; q < 9; ++q) { const int rw = min(lo + q, cur_hi); LAS unsigned char* d = lds + (rw % AT_NSLOT) * AT_SLOT + tid * 16;
                *(LAS v4u*)d = t[q][0]; *(LAS v4u*)(d + 8192) = t[q][1]; }
        }
        bf16x8 qf[2];
#pragma unroll
        for (int ks = 0; ks < 2; ++ks) qf[ks] = *(const bf16x8*)(Q + ((rowblk0 + r0 + rsub) * 8 + ks * 4 + quad) * 512 + c * 8);
        __syncthreads();
#pragma unroll 1
        for (int it = 0; it < 8; ++it) {
            const int ra = r0 + 2 * it, r = ra + rsub, rs = at_rs(r);
            const int nxt_hi = it < 7 ? at_rs(ra + 3) + 7 : cur_hi;
            v4u pre[2][2]; bf16x8 qn[2];
#pragma unroll
            for (int q = 0; q < 2; ++q) { const int rw = min(cur_hi + 1 + q, 31);
                pre[q][0] = *(const v4u*)(K + (rowblk0 + rw) * 4096 + tid * 8); pre[q][1] = *(const v4u*)(VT + (rowblk0 + rw) * 4096 + tid * 8); }
            { const int rn = min(r + 2, 31);
#pragma unroll
              for (int ks = 0; ks < 2; ++ks) qn[ks] = *(const bf16x8*)(Q + ((rowblk0 + rn) * 8 + ks * 4 + quad) * 512 + c * 8); }
            const size_t tokq = (size_t)b * SEQ + r * 64 + c;
            f32x4 S[16];
            int sl = rs % AT_NSLOT;
#pragma unroll
            for (int s = 0; s < 8; ++s) {
                const LAS unsigned char* kp = lds + sl * AT_SLOT + koff;
#pragma unroll
                for (int h2 = 0; h2 < 2; ++h2) {
                    const bf16x8 k0 = *(const LAS bf16x8*)(kp + h2 * 256), k1 = *(const LAS bf16x8*)(kp + 4096 + h2 * 256);
                    f32x4 a = (f32x4){0.f, 0.f, 0.f, 0.f};
                    a = __builtin_amdgcn_mfma_f32_16x16x32_bf16(k0, qf[0], a, 0, 0, 0);
                    a = __builtin_amdgcn_mfma_f32_16x16x32_bf16(k1, qf[1], a, 0, 0, 0);
                    S[2 * s + h2] = a;
                }
                sl = sl + 1 == AT_NSLOT ? 0 : sl + 1;
            }
            float xs[8][4]; float mx = -1e30f;
            const LAS float* tb = tbl + (rs - r + 7) * 31 + dcb;
#pragma unroll
            for (int i = 0; i < 4; ++i) {
                const LAS float* tbi = tb + i + (sel1[i] ? 16 : 0);
#pragma unroll
                for (int s = 0; s < 8; ++s) { const float x = (sel1[i] ? S[2 * s + 1][i] : S[2 * s][i]) + tbi[s * 31]; xs[s][i] = x; mx = fmaxf(mx, x); }
            }
            mx = fmaxf(mx, __shfl_xor(mx, 16)); mx = fmaxf(mx, __shfl_xor(mx, 32));
            float sum = 0.f;
#pragma unroll
            for (int s = 0; s < 8; ++s)
#pragma unroll
                for (int i = 0; i < 4; ++i) { const float p = __builtin_amdgcn_exp2f(xs[s][i] - mx); sum += p; S[2 * s][i] = sel1[i] ? 0.f : p; S[2 * s + 1][i] = sel1[i] ? p : 0.f; }
            sum += __shfl_xor(sum, 16); sum += __shfl_xor(sum, 32);
            const float inv = __builtin_amdgcn_rcpf(sum);
            f32x4 O[4];
#pragma unroll
            for (int db = 0; db < 4; ++db) O[db] = (f32x4){0.f, 0.f, 0.f, 0.f};
            sl = rs % AT_NSLOT;
#pragma unroll
            for (int s = 0; s < 8; ++s) {
                v4u pw; pw.x = pg8::cvt_pk_bf16(S[2 * s][0], S[2 * s][1]); pw.y = pg8::cvt_pk_bf16(S[2 * s][2], S[2 * s][3]);
                pw.z = pg8::cvt_pk_bf16(S[2 * s + 1][0], S[2 * s + 1][1]); pw.w = pg8::cvt_pk_bf16(S[2 * s + 1][2], S[2 * s + 1][3]);
                const bf16x8 pb = __builtin_bit_cast(bf16x8, pw);
                const LAS unsigned char* vp = lds + sl * AT_SLOT + voff;
#pragma unroll
                for (int db = 0; db < 4; ++db) {
                    const int o = (db ^ (quad & 1)) * 128;
                    const v2u lo = *(const LAS v2u*)(vp + o), hi = *(const LAS v2u*)(vp + o + 2048);
                    O[db] = __builtin_amdgcn_mfma_f32_16x16x32_bf16(__builtin_bit_cast(bf16x8, (v4u){lo.x, lo.y, hi.x, hi.y}), pb, O[db], 0, 0, 0);
                }
                sl = sl + 1 == AT_NSLOT ? 0 : sl + 1;
            }
            bf16* op = CAT + tokq * 1024 + h * 64 + 4 * quad;
#pragma unroll
            for (int db = 0; db < 4; ++db) { v2u o; o.x = pg8::cvt_pk_bf16(O[db][0] * inv, O[db][1] * inv); o.y = pg8::cvt_pk_bf16(O[db][2] * inv, O[db][3] * inv); *(v2u*)(op + 16 * db) = o; }
            __syncthreads();
#pragma unroll
            for (int q = 0; q < 2; ++q) { const int rw = cur_hi + 1 + q;
                if (rw <= nxt_hi) { LAS unsigned char* d = lds + (rw % AT_NSLOT) * AT_SLOT + tid * 16; *(LAS v4u*)d = pre[q][0]; *(LAS v4u*)(d + 8192) = pre[q][1]; } }
            cur_hi = nxt_hi; qf[0] = qn[0]; qf[1] = qn[1];
            __syncthreads();
        }
    }
    const int gw = vcu * NWAVES + wave, NGW = G * NWAVES;
    if (probe_mask & 2)
    for (int wb = gw; wb < (M / 64) * 4; wb += NGW) {
        const int g = wb & 3, tb = wb >> 2;
        if (g == 0) pool_block<1>(P, CAT, tb, g, lane); else if (g == 1) pool_block<2>(P, CAT, tb, g, lane); else if (g == 2) pool_block<4>(P, CAT, tb, g, lane); else pool_block<8>(P, CAT, tb, g, lane);
    }
    __syncthreads();
}

struct Args { const float* in[16]; float* out; unsigned char* ws; };
__global__ void __launch_bounds__(NWAVES * 64, 2) mega_fwd(Args args) {
    extern __shared__ __attribute__((aligned(16))) unsigned char lds_raw[];
    cg::grid_group grid = cg::this_grid();
    LAS unsigned char* lds = (LAS unsigned char*)lds_raw;
    const int tid = threadIdx.x, lane = tid & 63, wave = __builtin_amdgcn_readfirstlane(tid >> 6);
    const int G = gridDim.x, bx = blockIdx.x, vcu = (G % 8 == 0) ? (bx % 8) * (G / 8) + bx / 8 : bx;
    const int gw = vcu * NWAVES + wave, NGW = G * NWAVES;
    unsigned char* ws = args.ws;
    float* ssq = (float*)(ws + WS_SSQ); bf16* XB = (bf16*)(ws + WS_XB); bf16* HB = (bf16*)(ws + WS_H);
    bf16 *QB = (bf16*)(ws + WS_Q), *KB = (bf16*)(ws + WS_K), *PB = (bf16*)(ws + WS_P), *VT = (bf16*)(ws + WS_VT), *CAT = (bf16*)(ws + WS_CAT);
    float* xo = args.out;

    if (tid < 64) ((LAS unsigned*)(lds + MISC_OFF))[tid] = 0u;
    unsigned* barw = (unsigned*)(ws + WS_BAR);
    if (bx == 0) for (int i = tid; i < XCD_BAR_WORDS; i += NWAVES * 64) barw[i] = 0u;
    grid.sync();
    const XcdBarrier bar = xcd_barrier_post(barw, (volatile LAS unsigned*)(lds + MISC_OFF));
#pragma unroll 1
    for (int rep = 0; rep < 1 + (DUP_PRO ? 2 : 0); ++rep) {
        int pr = rep ? DUP_PRO : 3; asm volatile("" : "+s"(pr));
        prologue(args.in, ws, gw, NGW, lane, pr);
        xcd_barrier(bar);
    }
#define GRID_SYNC() xcd_barrier(bar)
#define LAUNDER_L() int ll = l; asm volatile("" : "+s"(ll)); const LayerW w = layer_w(args.in, ws, ll)
#pragma unroll 1
    for (int l = 0; l < DEPTH; ++l) {
        {
            LAUNDER_L();
            pg8::Gemm g{XB, w.GU1, M, 2 * FF, D}; pg8::StaticOrder S; S.init(M, 2 * FF, G, bx);
            pg8::EpiSwiglu E{HB, ssq + (size_t)(3 * ll) * M, FF};
            pg8::gemm_phase<pg8::EpiSwiglu, pg8::StaticOrder, true, true>(lds, g, S, E);
#if DUP_UP
            GRID_SYNC();
            pg8::gemm_phase<pg8::EpiSwiglu, pg8::StaticOrder, true, true>(lds, g, S, E);
#endif
        }
        GRID_SYNC();
#pragma unroll 1
        for (int rep = 0; rep < 1 + DUP_DOWN; ++rep) {
            LAUNDER_L();
            if (rep) GRID_SYNC();
            pg8::Gemm g{HB, w.D1, M, D, FF}; pg8::StaticOrder S; S.init(M, D, G, bx);
#if DUP_DOWN_NULL
            if (rep) { pg8::EpiNull EN{(float*)(ws + WS_END)}; pg8::gemm_phase<pg8::EpiNull, pg8::StaticOrder, true, true>(lds, g, S, EN); continue; }
#endif
            pg8::EpiRes E{XB, rep ? (float*)(ws + WS_END) : ssq + (size_t)(3 * ll + 1) * M, rep ? 0.0f : 0.5f};
            pg8::gemm_phase<pg8::EpiRes, pg8::StaticOrder, true, true>(lds, g, S, E);
        }
        GRID_SYNC();
#pragma unroll 1
        for (int rep = 0; rep < 1 + DUP_IN; ++rep) {
            LAUNDER_L();
            if (rep) GRID_SYNC();
            {
                pg8::Gemm g{XB, w.WIN, M, 1536, D}; pg8::WinOrder S; S.init(M, G, bx);
                pg8::EpiZV E{pg8::EpiZ{QB, PB, ssq + (size_t)(3 * ll + 1) * M, (size_t)(WS_K - WS_Q) / 2}, pg8::EpiVT{VT, ssq + (size_t)(3 * ll + 1) * M}};
                pg8::gemm_phase<pg8::EpiZV, pg8::WinOrder, true, true>(lds, g, S, E);
            }
        }
        GRID_SYNC();
#pragma unroll 1
        for (int rep = 0; rep < 1 + DUP_ATTN; ++rep) {
            LAUNDER_L();
            int t2 = threadIdx.x; asm volatile("" : "+v"(t2));
            if (rep) GRID_SYNC();
            int pm_ = rep ? ATT_PROBE_MASK : 3; asm volatile("" : "+s"(pm_));
            attn_pool_phase(lds, QB, KB, VT, PB, CAT, w.rpb, vcu, G, __builtin_amdgcn_readfirstlane(t2 >> 6), t2 & 63, t2, pm_);
        }
        GRID_SYNC();
#pragma unroll 1
        for (int rep = 0; rep < 1 + DUP_WOUT; ++rep) {
            LAUNDER_L();
            if (rep) GRID_SYNC();
            pg8::Gemm g{CAT, w.WOUT, M, D, D}; pg8::StaticOrder S; S.init(M, D, G, bx);
            pg8::EpiRes E{XB, rep ? (float*)(ws + WS_END) : ssq + (size_t)(3 * ll + 2) * M, rep ? 0.0f : 1.0f};
            pg8::gemm_phase<pg8::EpiRes, pg8::StaticOrder, true, true>(lds, g, S, E);
        }
        GRID_SYNC();
        {
            LAUNDER_L();
            pg8::Gemm g{XB, w.GU2, M, 2 * FF, D}; pg8::StaticOrder S; S.init(M, 2 * FF, G, bx);
            pg8::EpiSwiglu E{HB, ssq + (size_t)(3 * ll + 2) * M, FF};
            pg8::gemm_phase<pg8::EpiSwiglu, pg8::StaticOrder, true, true>(lds, g, S, E);
        }
        GRID_SYNC();
        {
            LAUNDER_L();
            pg8::Gemm g{HB, w.D2, M, D, FF}; pg8::StaticOrder S; S.init(M, D, G, bx);
            if (ll == DEPTH - 1 && G == 256) {
                pg8::EpiResFinal EF{XB, ssq + (size_t)(3 * DEPTH) * M, (unsigned*)(ws + WS_PCNT), args.in[15], xo, 0.5f};
                pg8::gemm_phase<pg8::EpiResFinal, pg8::StaticOrder, true, true>(lds, g, S, EF);
            } else {
                pg8::EpiRes E{XB, ssq + (size_t)(3 * ll + 3) * M, 0.5f};
                pg8::gemm_phase<pg8::EpiRes, pg8::StaticOrder, true, true>(lds, g, S, E);
                GRID_SYNC();
            }
        }
    }
    if (G != 256) {
        int t2 = threadIdx.x; asm volatile("" : "+v"(t2)); const int ln = t2 & 63, gwf = vcu * NWAVES + __builtin_amdgcn_readfirstlane(t2 >> 6);
        const float* gn = args.in[15]; const float* sf = ssq + (size_t)(3 * DEPTH) * M;
        for (int m = gwf; m < M; m += NGW) {
            const float rs = pg8::rstd_of(sf[m]); f32x4* xr = (f32x4*)(xo + (size_t)m * D) + ln; const f32x4* gr = (const f32x4*)gn + ln;
            const v2u* hr = (const v2u*)(XB + (size_t)m * D) + ln;
#pragma unroll
            for (int jj = 0; jj < 4; ++jj) { const v2u hw = hr[64 * jj];
                const f32x4 v = (f32x4){bflo(hw.x), bfhi(hw.x), bflo(hw.y), bfhi(hw.y)};
                xr[64 * jj] = v * rs * gr[64 * jj]; }
        }
    }
}

extern "C" void kernel_launch(void* const* d_in, const int* in_sizes, int n_in, void* d_out, int out_size, void* d_ws, size_t ws_size, hipStream_t stream) {
    static int grid = 0;
    if (grid == 0) {
        if (n_in != 16 || in_sizes[0] != M * D || out_size != M * D || ws_size < WS_END) { fprintf(stderr, "kernel_launch: unexpected shapes (n_in %d, in0 %d, out %d, ws %zu)\n", n_in, n_in > 0 ? in_sizes[0] : -1, out_size, ws_size); grid = -1; return; }
        int dev = 0, cus = 0, per_cu = 0;
        if (hipGetDevice(&dev) != hipSuccess || hipDeviceGetAttribute(&cus, hipDeviceAttributeMultiprocessorCount, dev) != hipSuccess) { grid = -1; return; }
        if (hipFuncSetAttribute((const void*)mega_fwd, hipFuncAttributeMaxDynamicSharedMemorySize, LDS_BYTES) != hipSuccess) { fprintf(stderr, "kernel_launch: hipFuncSetAttribute failed\n"); grid = -1; return; }
        if (hipOccupancyMaxActiveBlocksPerMultiprocessor(&per_cu, (const void*)mega_fwd, NWAVES * 64, LDS_BYTES) != hipSuccess || per_cu < 1) { fprintf(stderr, "kernel_launch: occupancy query gave %d\n", per_cu); per_cu = 1; }
        (void)hipGetLastError();
        grid = cus * 1;
    }
    if (grid < 0) return;
    Args a{};
    for (int i = 0; i < 16; ++i) a.in[i] = (const float*)d_in[i];
    a.out = (float*)d_out; a.ws = (unsigned char*)d_ws;
    void* kargs[] = {&a};
    const hipError_t e = hipLaunchCooperativeKernel((const void*)mega_fwd, dim3(grid), dim3(NWAVES * 64), kargs, LDS_BYTES, stream);
    if (e != hipSuccess) fprintf(stderr, "kernel_launch: cooperative launch failed: %s (grid %d)\n", hipGetErrorString(e), grid);
}
```

```cpp
#include <hip/hip_runtime.h>
#include <hip/hip_cooperative_groups.h>
#include <cstdio>
#include <cstdint>
namespace cg = cooperative_groups;
#define DUP_PRO 0
#define DUP_UP 0
#define DUP_ATTN 0
#define DUP_DOWN 0
#define DUP_IN 0
#define DUP_WOUT 0
#define ATT_PROBE_MASK 3
#define DUP_DOWN_NULL 0
namespace pg8 {
#define PG8_LAS __attribute__((address_space(3)))
typedef unsigned short bf16_t;
typedef short bf16x8 __attribute__((ext_vector_type(8)));
typedef float f32x4 __attribute__((ext_vector_type(4)));
typedef unsigned u32x4 __attribute__((ext_vector_type(4)));
constexpr int BM = 256, BK = 64, HALF = 128, HTB = HALF * BK * 2  , STAGE_BYTES = 8 * HTB, NXCD = 8, WGM = 8;

__host__ __device__ __forceinline__ int lds_byte(int r, int c) { const int st = (r >> 4) * 2 + (c >> 5), rr = r & 15, cc = c & 31, ob = rr * 64 + cc * 2; return st * 1024 + (ob ^ (((ob >> 9) & 1) << 5)); }
__host__ __device__ __forceinline__ void stage_rc(int b, int& R, int& C) { const int st = b / 1024, sb = b % 1024, swz = sb ^ (((sb >> 9) & 1) << 5); R = (st >> 1) * 16 + swz / 64; C = (st & 1) * 32 + (swz % 64) / 2; }
__host__ __device__ __forceinline__ int perm32(int rho) { const int n = rho >> 4, i = rho & 15; return 8 * (i >> 2) + 4 * n + (i & 3); }

struct Unit { int pm, pn, swp; };
struct Gemm { const bf16_t* A; const bf16_t* Bt; int M, N, K; };

struct StaticOrder {
    int nM, nN, nwg, G, c;
    __host__ __device__ void init(int M, int N, int G_, int c_) { nM = M / BM; nN = N / BM; nwg = nM * nN; G = G_; c = c_; }
    __host__ __device__ bool next(int i, Unit& u) const {
        const long L = (long)i * G + c; if (L >= nwg) return false;
        int wgid = (int)L; { const int q = nwg / NXCD, r = nwg % NXCD, xcd = wgid % NXCD, off = wgid / NXCD; wgid = (xcd < r ? xcd * (q + 1) : r * (q + 1) + (xcd - r) * q) + off; }
        const int nig = WGM * nN, gid = wgid / nig, fm = gid * WGM, gsz = (nM - fm) < WGM ? (nM - fm) : WGM;
        u.pm = fm + ((wgid % nig) % gsz); u.pn = (wgid % nig) / gsz; u.swp = 0; return true;
    }
    __device__ __forceinline__ void a_ready(const Unit&) const {}
    __device__ __forceinline__ void done(const Unit&) const {}
};

typedef float f32x2_cv __attribute__((ext_vector_type(2))); typedef __bf16 bf16x2_cv __attribute__((ext_vector_type(2)));
__device__ __forceinline__ unsigned cvt_pk_bf16(float lo, float hi) { const f32x2_cv v = {lo, hi}; return __builtin_bit_cast(unsigned, __builtin_convertvector(v, bf16x2_cv)); }
typedef float f32x2 __attribute__((ext_vector_type(2)));
constexpr float RMS_EPS_C = 1e-6f;
__device__ __forceinline__ float rstd_of(float ss) { return __builtin_amdgcn_rsqf(ss * (1.0f / 1024.0f) + RMS_EPS_C); }
__device__ __forceinline__ float silu_mul(float g, float u) { return g * __builtin_amdgcn_rcpf(1.0f + __builtin_amdgcn_exp2f(g * -1.4426950408889634f)) * u; }

typedef float f32x2v __attribute__((ext_vector_type(2)));
struct EpiSwiglu {
    static constexpr bool PERM = true, AFTER_DRAIN = false;
    bf16_t* H; const float* ssq; int ldh;
    __device__ __forceinline__ void operator()(const f32x4 (&acc)[2][2][4][2], const Unit& u, int wr, int wc, int fr, int fq) const {
        const int row0 = u.pm * BM + wr * 64 + fr, col0 = u.pn * 128 + wc * 32 + 8 * fq;
        float rsv[2][4];
#pragma unroll
        for (int ai = 0; ai < 2; ++ai)
#pragma unroll
            for (int m = 0; m < 4; ++m) rsv[ai][m] = ssq[row0 + ai * HALF + m * 16];
        __builtin_amdgcn_sched_barrier(0);
#pragma unroll
        for (int ai = 0; ai < 2; ++ai)
#pragma unroll
            for (int m = 0; m < 4; ++m) {
                const int row = row0 + ai * HALF + m * 16; const float rs = rstd_of(rsv[ai][m]), k1 = rs * -1.4426950408889634f, rs2 = rs * rs;
                u32x4 w;
#pragma unroll
                for (int n = 0; n < 2; ++n)
#pragma unroll
                    for (int hp = 0; hp < 2; ++hp) {
                        const f32x2v g = (f32x2v){acc[ai][0][m][n][2 * hp], acc[ai][0][m][n][2 * hp + 1]}, uu = (f32x2v){acc[ai][1][m][n][2 * hp], acc[ai][1][m][n][2 * hp + 1]};
                        const f32x2v p = (g * uu) * rs2, a = g * k1;
                        f32x2v t; t.x = __builtin_amdgcn_exp2f(a.x); t.y = __builtin_amdgcn_exp2f(a.y);
                        const f32x2v d = t + 1.0f;
                        f32x2v r; r.x = __builtin_amdgcn_rcpf(d.x); r.y = __builtin_amdgcn_rcpf(d.y);
                        const f32x2v hv = p * r;
                        w[2 * n + hp] = cvt_pk_bf16(hv.x, hv.y);
                    }
                *(u32x4*)(H + (size_t)row * ldh + col0) = w;
            }
    }
};
typedef unsigned u32x2 __attribute__((ext_vector_type(2)));
struct EpiRes {
    static constexpr bool PERM = true, AFTER_DRAIN = false;
    bf16_t* xh; float* ssq_out; float alpha;
    __device__ __forceinline__ void load4(u32x4 (&hv)[4][2], size_t off0) const {
#pragma unroll
        for (int m = 0; m < 4; ++m)
#pragma unroll
            for (int bj = 0; bj < 2; ++bj) hv[m][bj] = *(const u32x4*)(xh + off0 + (size_t)m * 16 * 1024 + bj * HALF);
    }
    __device__ __forceinline__ float group(const f32x4 (&a)[2][4][2], int m, const u32x4 (&hv)[2], size_t off) const {
        float ss = 0.f;
#pragma unroll
        for (int bj = 0; bj < 2; ++bj) {
            float o[8];
#pragma unroll
            for (int e = 0; e < 8; ++e) {
                const unsigned hw = hv[bj][e >> 1];
                const float base = __builtin_bit_cast(float, (e & 1) ? (hw & 0xffff0000u) : (hw << 16));
                o[e] = base + a[bj][m][e >> 2][e & 3] * alpha; ss += o[e] * o[e];
            }
            u32x4 w; w.x = cvt_pk_bf16(o[0], o[1]); w.y = cvt_pk_bf16(o[2], o[3]); w.z = cvt_pk_bf16(o[4], o[5]); w.w = cvt_pk_bf16(o[6], o[7]);
            *(u32x4*)(xh + off + bj * HALF) = w;
        }
        ss += __shfl_xor(ss, 16); ss += __shfl_xor(ss, 32);
        return ss;
    }
    __device__ __forceinline__ void operator()(const f32x4 (&acc)[2][2][4][2], const Unit& u, int wr, int wc, int fr, int fq) const {
        const int row0 = u.pm * BM + wr * 64 + fr, col0 = u.pn * BM + wc * 32 + 8 * fq;
        const size_t off0 = (size_t)row0 * 1024 + col0, off1 = off0 + (size_t)HALF * 1024;
        u32x4 hA[4][2], hB[4][2];
        load4(hA, off0); load4(hB, off1);
        __builtin_amdgcn_sched_barrier(0);
        const int rbase = u.pm * BM + wr * 64 + 16 * fq + fr;
        float sa[4], sb[4];
#pragma unroll
        for (int m = 0; m < 4; ++m) sa[m] = group(acc[0], m, hA[m], off0 + (size_t)m * 16 * 1024);
        atomicAdd(ssq_out + rbase, fq == 0 ? sa[0] : fq == 1 ? sa[1] : fq == 2 ? sa[2] : sa[3]);
#pragma unroll
        for (int m = 0; m < 4; ++m) sb[m] = group(acc[1], m, hB[m], off1 + (size_t)m * 16 * 1024);
        atomicAdd(ssq_out + rbase + HALF, fq == 0 ? sb[0] : fq == 1 ? sb[1] : fq == 2 ? sb[2] : sb[3]);
    }
};
struct EpiResFinal {
    static constexpr bool PERM = true, AFTER_DRAIN = false;
    const bf16_t* xh; float* ssq_out; unsigned* cnt; const float* gain; float* out; float alpha;
    __device__ __forceinline__ void operator()(const f32x4 (&acc_c)[2][2][4][2], const Unit& u, int wr, int wc, int fr, int fq) const {
        f32x4 (&acc)[2][2][4][2] = const_cast<f32x4 (&)[2][2][4][2]>(acc_c);
        const int row0 = u.pm * BM + wr * 64 + fr, col0 = u.pn * BM + wc * 32 + 8 * fq;
        const size_t off0 = (size_t)row0 * 1024 + col0;
        u32x4 hv[2][4][2];
#pragma unroll
        for (int ai = 0; ai < 2; ++ai)
#pragma unroll
            for (int m = 0; m < 4; ++m)
#pragma unroll
                for (int bj = 0; bj < 2; ++bj) hv[ai][m][bj] = *(const u32x4*)(xh + off0 + (size_t)(ai * HALF + m * 16) * 1024 + bj * HALF);
        __builtin_amdgcn_sched_barrier(0);
#pragma unroll
        for (int ai = 0; ai < 2; ++ai) {
            float sv[4];
#pragma unroll
            for (int m = 0; m < 4; ++m) {
                float ss = 0.f;
#pragma unroll
                for (int bj = 0; bj < 2; ++bj)
#pragma unroll
                    for (int e = 0; e < 8; ++e) {
                        const unsigned hw = hv[ai][m][bj][e >> 1];
                        const float base = __builtin_bit_cast(float, (e & 1) ? (hw & 0xffff0000u) : (hw << 16));
                        const float o = base + acc[ai][bj][m][e >> 2][e & 3] * alpha; acc[ai][bj][m][e >> 2][e & 3] = o; ss += o * o;
                    }
                ss += __shfl_xor(ss, 16); ss += __shfl_xor(ss, 32);
                sv[m] = ss;
            }
            atomicAdd(ssq_out + u.pm * BM + wr * 64 + ai * HALF + 16 * fq + fr, fq == 0 ? sv[0] : fq == 1 ? sv[1] : fq == 2 ? sv[2] : sv[3]);
        }
        asm volatile("s_waitcnt vmcnt(0)" ::: "memory");
        unsigned* pc = cnt + 64 * u.pm;
        if ((threadIdx.x & 63) == 0) __hip_atomic_fetch_add(pc, 1u, __ATOMIC_RELAXED, __HIP_MEMORY_SCOPE_AGENT);
        { unsigned spins = 0;
          while ((unsigned)__builtin_amdgcn_readfirstlane(__hip_atomic_load(pc, __ATOMIC_RELAXED, __HIP_MEMORY_SCOPE_AGENT)) < 32u) { __builtin_amdgcn_s_sleep(2); if (++spins > (1u << 16)) break; } }
        float rs[2][4];
#pragma unroll
        for (int ai = 0; ai < 2; ++ai)
#pragma unroll
            for (int m = 0; m < 4; ++m) rs[ai][m] = rstd_of(__hip_atomic_load(ssq_out + row0 + ai * HALF + m * 16, __ATOMIC_RELAXED, __HIP_MEMORY_SCOPE_AGENT));
        f32x4 gv[2][2];
#pragma unroll
        for (int bj = 0; bj < 2; ++bj) { gv[bj][0] = *(const f32x4*)(gain + col0 + bj * HALF); gv[bj][1] = *(const f32x4*)(gain + col0 + bj * HALF + 4); }
#pragma unroll
        for (int ai = 0; ai < 2; ++ai)
#pragma unroll
            for (int m = 0; m < 4; ++m)
#pragma unroll
                for (int bj = 0; bj < 2; ++bj) {
                    float* op = out + off0 + (size_t)(ai * HALF + m * 16) * 1024 + bj * HALF;
                    *(f32x4*)op = acc[ai][bj][m][0] * rs[ai][m] * gv[bj][0]; *(f32x4*)(op + 4) = acc[ai][bj][m][1] * rs[ai][m] * gv[bj][1];
                }
    }
};
struct EpiZ {
    static constexpr bool PERM = true, AFTER_DRAIN = false;
    bf16_t *Q, *P; const float* ssq; size_t qk_stride, b_stride;
    __device__ __forceinline__ void operator()(const f32x4 (&acc)[2][2][4][2], const Unit& u, int wr, int wc, int fr, int fq) const {
        const int row0 = u.pm * BM + wr * 64 + fr, kind = u.pn >> 1;
        float rsv[2][4];
#pragma unroll
        for (int ai = 0; ai < 2; ++ai)
#pragma unroll
            for (int m = 0; m < 4; ++m) rsv[ai][m] = ssq[row0 + ai * HALF + m * 16];
        __builtin_amdgcn_sched_barrier(0);
        if (kind == 2) {
            const int colt = (u.pn & 1) * BM + wc * 32 + 8 * fq;
#pragma unroll
            for (int ai = 0; ai < 2; ++ai)
#pragma unroll
                for (int m = 0; m < 4; ++m) {
                    const int row = row0 + ai * HALF + m * 16; const float rs = rstd_of(rsv[ai][m]);
#pragma unroll
                    for (int bj = 0; bj < 2; ++bj) {
                        const f32x4 v0 = acc[ai][bj][m][0] * rs, v1 = acc[ai][bj][m][1] * rs;
                        u32x4 w; w.x = cvt_pk_bf16(v0[0], v0[1]); w.y = cvt_pk_bf16(v0[2], v0[3]); w.z = cvt_pk_bf16(v1[0], v1[1]); w.w = cvt_pk_bf16(v1[2], v1[3]);
                        *(u32x4*)(P + (size_t)row * 512 + colt + bj * HALF) = w;
                    }
                }
        } else {
            bf16_t* dst = Q + (size_t)kind * qk_stride; const float sc = kind == 0 ? 0.125f * 1.4426950408889634f : 1.0f;
            const int b = u.pm >> 3, h0 = 4 * (u.pn & 1) + (wc >> 1), ks = wc & 1;
#pragma unroll
            for (int ai = 0; ai < 2; ++ai)
#pragma unroll
                for (int m = 0; m < 4; ++m) {
                    const float rs = rstd_of(rsv[ai][m]) * sc;
                    const int grow = (u.pm & 7) * 4 + 2 * ai + wr, col = 16 * m + fr;
#pragma unroll
                    for (int bj = 0; bj < 2; ++bj) {
                        const f32x4 v0 = acc[ai][bj][m][0] * rs, v1 = acc[ai][bj][m][1] * rs;
                        u32x4 w; w.x = cvt_pk_bf16(v0[0], v0[1]); w.y = cvt_pk_bf16(v0[2], v0[3]); w.z = cvt_pk_bf16(v1[0], v1[1]); w.w = cvt_pk_bf16(v1[2], v1[3]);
                        const size_t idx = (size_t)b * b_stride + ((((size_t)((h0 + 2 * bj) * 32 + grow) * 2 + ks) * 4 + fq) * 64 + col) * 8;
                        *(u32x4*)(dst + idx) = w;
                    }
                }
        }
    }
};
struct EpiVT {
    static constexpr bool PERM = true, AFTER_DRAIN = false;
    bf16_t* VF; const float* ssq;
    __device__ __forceinline__ void operator()(const f32x4 (&acc)[2][2][4][2], const Unit& u, int wr, int wc, int fr, int fq) const {
        typedef unsigned u32x2 __attribute__((ext_vector_type(2)));
        const int b = u.pn >> 3, tok0 = u.pn * BM + wc * 32 + 8 * fq;
        f32x4 sqv[2][2];
#pragma unroll
        for (int bj = 0; bj < 2; ++bj)
#pragma unroll
            for (int n = 0; n < 2; ++n) sqv[bj][n] = *(const f32x4*)(ssq + tok0 + bj * HALF + 4 * n);
        __builtin_amdgcn_sched_barrier(0);
#pragma unroll
        for (int bj = 0; bj < 2; ++bj)
#pragma unroll
            for (int n = 0; n < 2; ++n) {
                const f32x4 sq = sqv[bj][n];
                const f32x4 rs = (f32x4){rstd_of(sq[0]), rstd_of(sq[1]), rstd_of(sq[2]), rstd_of(sq[3])};
                const int grow = (u.pn & 7) * 4 + 2 * bj + (wc >> 1), cg = (wc & 1) * 8 + 2 * fq + n;
#pragma unroll
                for (int ai = 0; ai < 2; ++ai)
#pragma unroll
                    for (int m = 0; m < 4; ++m) {
                        const int h = 4 * u.pm + 2 * ai + wr;
                        const f32x4 v = acc[ai][bj][m][n] * rs;
                        u32x2 w; w.x = cvt_pk_bf16(v[0], v[1]); w.y = cvt_pk_bf16(v[2], v[3]);
                        *(u32x2*)(VF + ((((size_t)((b * 8 + h) * 32 + grow) * 16 + cg) * 64 + ((m ^ n) * 16 + fr)) * 4)) = w;
                    }
            }
    }
};

struct EpiNull {
    static constexpr bool PERM = true, AFTER_DRAIN = false;
    float* out;
    __device__ __forceinline__ void operator()(const f32x4 (&acc)[2][2][4][2], const Unit& u, int wr, int wc, int fr, int fq) const {
        float s = 0.f;
#pragma unroll
        for (int ai = 0; ai < 2; ++ai)
#pragma unroll
            for (int bj = 0; bj < 2; ++bj)
#pragma unroll
                for (int m = 0; m < 4; ++m)
#pragma unroll
                    for (int n = 0; n < 2; ++n) s += acc[ai][bj][m][n][0] + acc[ai][bj][m][n][1] + acc[ai][bj][m][n][2] + acc[ai][bj][m][n][3];
        if (s == 1.2345e38f) out[u.pm] = s;
    }
};

struct WinOrder {
    StaticOrder z, v; int nzc;
    __device__ void init(int M, int G, int c) { z.init(M, 1536, G, c); v.init(512, M, G, c); nzc = (z.nwg - c + G - 1) / G; if (nzc < 0) nzc = 0; }
    __device__ bool next(int i, Unit& u) const {
        if (i < nzc) return z.next(i, u);
        if (!v.next(i - nzc, u)) return false;
        u.pm += 6; u.swp = 1; return true;
    }
    __device__ __forceinline__ void a_ready(const Unit&) const {}
    __device__ __forceinline__ void done(const Unit&) const {}
};
struct EpiZV {
    static constexpr bool PERM = true, AFTER_DRAIN = false;
    EpiZ ez; EpiVT ev;
    __device__ __forceinline__ void operator()(const f32x4 (&acc)[2][2][4][2], const Unit& u, int wr, int wc, int fr, int fq) const {
        if (u.swp) { Unit uv; uv.pm = u.pm - 6; uv.pn = u.pn; uv.swp = 1; ev(acc, uv, wr, wc, fr, fq); } else ez(acc, u, wr, wc, fr, fq);
    }
};
template <class Epi, class Sched, bool ALIGN_EPI = false, bool SP2 = false>
__device__ __forceinline__ void gemm_phase(PG8_LAS unsigned char* lds, const Gemm g, const Sched& S, const Epi& E) {
    int tid_ = threadIdx.x; asm volatile("" : "+v"(tid_));
    const int tid = tid_, wid = __builtin_amdgcn_readfirstlane(tid >> 6), lane = tid & 63, wr = wid >> 2, wc = wid & 3, fr = lane & 15, fq = lane >> 4;
    const int K = g.K, nt = K / BK;
    unsigned voffA[2], voffB[2];
#pragma unroll
    for (int i = 0; i < 2; ++i) { int R, C; stage_rc(tid * 16 + i * 8192, R, C); const int Rb = Epi::PERM ? ((R & ~31) + perm32(R & 31)) : R;
        voffA[i] = (unsigned)(R * K + C) * 2u; voffB[i] = (unsigned)(Rb * K + C) * 2u; }
    const size_t kstep = (size_t)(BK * 2);
    const size_t hstep = (size_t)HALF * K * 2;
    const size_t tstep = 2 * hstep;
    const unsigned ldsw = (unsigned)wid * 1024u;
    const int aoff = lds_byte(wr * 64 + fr, fq * 8), boff = lds_byte(wc * 32 + fr, fq * 8);
#define PG8_SA(b, h) (((b) * 2 + (h)) * HTB)
#define PG8_SB(b, h) ((4 + (b) * 2 + (h)) * HTB)
#define PG8_STAGE(bufoff, gbase, voff) do { _Pragma("unroll") for (int _i = 0; _i < 2; ++_i) \
        __builtin_amdgcn_global_load_lds((const unsigned*)((const char*)(gbase) + (voff)[_i]), (PG8_LAS unsigned*)(lds + (bufoff) + ldsw + _i * 8192), 16, 0, 0); } while (0)
#define PG8_LDA(dst, b, h) do { _Pragma("unroll") for (int m = 0; m < 4; ++m) _Pragma("unroll") for (int k = 0; k < 2; ++k) dst[m][k] = *(const PG8_LAS bf16x8*)(lds + PG8_SA(b, h) + aoff + m * 2048 + k * 1024); } while (0)
#define PG8_LDB(dst, b, h) do { _Pragma("unroll") for (int n = 0; n < 2; ++n) _Pragma("unroll") for (int k = 0; k < 2; ++k) dst[n][k] = *(const PG8_LAS bf16x8*)(lds + PG8_SB(b, h) + boff + n * 2048 + k * 1024); } while (0)
#define PG8_MMA(ai, bj, At, Bt) do { __builtin_amdgcn_s_setprio(1); _Pragma("unroll") for (int m = 0; m < 4; ++m) _Pragma("unroll") for (int n = 0; n < 2; ++n) _Pragma("unroll") for (int k = 0; k < 2; ++k) \
        acc[ai][bj][m][n] = __builtin_amdgcn_mfma_f32_16x16x32_bf16(Bt[n][k], At[m][k], acc[ai][bj][m][n], 0, 0, 0); __builtin_amdgcn_s_setprio(0); } while (0)
#define PG8_WAIT_V(n) asm volatile("s_waitcnt vmcnt(" #n ")" ::: "memory")
#define PG8_WAIT_L(n) asm volatile("s_waitcnt lgkmcnt(" #n ")" ::: "memory")
#define PG8_BAR __builtin_amdgcn_s_barrier()
#define PG8_SCHED __builtin_amdgcn_sched_barrier(0)
    Unit cur, nxt; int ui = 0;
    if (!S.next(0, cur)) return;
    f32x4 acc[2][2][4][2];
#pragma unroll
    for (int a = 0; a < 2; ++a)
#pragma unroll
        for (int b = 0; b < 2; ++b)
#pragma unroll
            for (int m = 0; m < 4; ++m)
#pragma unroll
                for (int n = 0; n < 2; ++n) acc[a][b][m][n] = (f32x4){0.f, 0.f, 0.f, 0.f};
    bf16x8 At[4][2], B0[2][2], B1[2][2];
    const char* cA = (const char*)(cur.swp ? g.Bt : g.A) + (size_t)cur.pm * tstep; const char* cB = (const char*)(cur.swp ? g.A : g.Bt) + (size_t)cur.pn * tstep;
    S.a_ready(cur);
    if constexpr (SP2) {
        PG8_STAGE(PG8_SB(0, 0), cB, voffB); PG8_STAGE(PG8_SB(0, 1), cB + hstep, voffB); PG8_STAGE(PG8_SA(0, 0), cA, voffA); PG8_STAGE(PG8_SA(0, 1), cA + hstep, voffA);
        if (wr == 1) PG8_BAR;
        PG8_WAIT_V(2); PG8_BAR;
        PG8_STAGE(PG8_SB(1, 0), cB + kstep, voffB); PG8_STAGE(PG8_SA(1, 0), cA + kstep, voffA); PG8_STAGE(PG8_SB(1, 1), cB + hstep + kstep, voffB);
        PG8_WAIT_V(6); PG8_BAR;
    } else {
        PG8_STAGE(PG8_SB(0, 0), cB, voffB); PG8_STAGE(PG8_SA(0, 0), cA, voffA); PG8_STAGE(PG8_SB(0, 1), cB + hstep, voffB); PG8_STAGE(PG8_SA(0, 1), cA + hstep, voffA);
        if (wr == 1) PG8_BAR;
        PG8_WAIT_V(4); PG8_BAR;
        PG8_STAGE(PG8_SB(1, 0), cB + kstep, voffB); PG8_STAGE(PG8_SA(1, 0), cA + kstep, voffA); PG8_STAGE(PG8_SB(1, 1), cB + hstep + kstep, voffB);
        PG8_WAIT_V(6); PG8_BAR;
    }
    for (;;) {
        const bool has_next = S.next(ui + 1, nxt);
        const char* nA = has_next ? (const char*)(nxt.swp ? g.Bt : g.A) + (size_t)nxt.pm * tstep : cA; const char* nB = has_next ? (const char*)(nxt.swp ? g.A : g.Bt) + (size_t)nxt.pn * tstep : cB;
        for (int t = 0; t < nt; t += 2) {
            const bool last = (t == nt - 2);
            const char* a1 = cA + (size_t)(t + 1) * kstep;
            const char* a2 = last ? nA : cA + (size_t)(t + 2) * kstep; const char* b2 = last ? nB : cB + (size_t)(t + 2) * kstep;
            const char* a3 = a2 + kstep; const char* b3 = b2 + kstep;
            if (last && has_next) S.a_ready(nxt);
            if constexpr (SP2) {
            PG8_LDB(B0, 0, 0); PG8_LDB(B1, 0, 1); PG8_SCHED; PG8_LDA(At, 0, 0); PG8_STAGE(PG8_SA(1, 1), a1 + hstep, voffA);
            PG8_WAIT_V(8); PG8_WAIT_L(0); PG8_BAR; PG8_MMA(0, 0, At, B0); PG8_MMA(0, 1, At, B1); PG8_BAR; PG8_SCHED;
            PG8_LDA(At, 0, 1); PG8_STAGE(PG8_SB(0, 0), b2, voffB); PG8_STAGE(PG8_SB(0, 1), b2 + hstep, voffB); PG8_STAGE(PG8_SA(0, 0), a2, voffA);
            PG8_WAIT_V(8); PG8_WAIT_L(0); PG8_BAR; PG8_MMA(1, 0, At, B0); PG8_MMA(1, 1, At, B1); PG8_BAR; PG8_SCHED;
            PG8_LDB(B0, 1, 0); PG8_LDB(B1, 1, 1); PG8_SCHED; PG8_LDA(At, 1, 0); PG8_STAGE(PG8_SA(0, 1), a2 + hstep, voffA);
            PG8_WAIT_V(8); PG8_WAIT_L(0); PG8_BAR; PG8_MMA(0, 0, At, B0); PG8_MMA(0, 1, At, B1); PG8_BAR; PG8_SCHED;
            PG8_LDA(At, 1, 1); PG8_STAGE(PG8_SB(1, 0), b3, voffB); PG8_STAGE(PG8_SB(1, 1), b3 + hstep, voffB); PG8_STAGE(PG8_SA(1, 0), a3, voffA);
            PG8_WAIT_V(8); PG8_WAIT_L(0); PG8_BAR; PG8_MMA(1, 0, At, B0); PG8_MMA(1, 1, At, B1); PG8_BAR; PG8_SCHED;
            } else {
            PG8_LDB(B0, 0, 0); PG8_SCHED; PG8_LDA(At, 0, 0); PG8_STAGE(PG8_SA(1, 1), a1 + hstep, voffA);
            PG8_WAIT_L(8); PG8_BAR; PG8_WAIT_L(0); PG8_MMA(0, 0, At, B0); PG8_BAR; PG8_SCHED;
            PG8_LDB(B1, 0, 1); PG8_STAGE(PG8_SB(0, 0), b2, voffB);
            PG8_BAR; PG8_WAIT_L(0); PG8_MMA(0, 1, At, B1); PG8_BAR;
            PG8_LDA(At, 0, 1); PG8_STAGE(PG8_SA(0, 0), a2, voffA);
            PG8_BAR; PG8_WAIT_L(0); PG8_MMA(1, 0, At, B0); PG8_BAR; PG8_SCHED;
            PG8_STAGE(PG8_SB(0, 1), b2 + hstep, voffB);
            PG8_WAIT_V(6); PG8_BAR; PG8_MMA(1, 1, At, B1); PG8_BAR;
            PG8_LDB(B0, 1, 0); PG8_SCHED; PG8_LDA(At, 1, 0); PG8_STAGE(PG8_SA(0, 1), a2 + hstep, voffA);
            PG8_WAIT_L(8); PG8_BAR; PG8_WAIT_L(0); PG8_MMA(0, 0, At, B0); PG8_BAR; PG8_SCHED;
            PG8_LDB(B1, 1, 1); PG8_STAGE(PG8_SB(1, 0), b3, voffB);
            PG8_BAR; PG8_WAIT_L(0); PG8_MMA(0, 1, At, B1); PG8_BAR;
            PG8_LDA(At, 1, 1); PG8_STAGE(PG8_SA(1, 0), a3, voffA);
            PG8_BAR; PG8_WAIT_L(0); PG8_MMA(1, 0, At, B0); PG8_BAR; PG8_SCHED;
            PG8_STAGE(PG8_SB(1, 1), b3 + hstep, voffB);
            PG8_WAIT_V(6); PG8_BAR; PG8_MMA(1, 1, At, B1); PG8_BAR;
            }
        }
        if constexpr (ALIGN_EPI) { if (wr == 0) PG8_BAR; }
        if constexpr (!Epi::AFTER_DRAIN) { E(acc, cur, wr, wc, fr, fq); S.done(cur); }
        if (!has_next) break;
#pragma unroll
        for (int a = 0; a < 2; ++a)
#pragma unroll
            for (int b = 0; b < 2; ++b)
#pragma unroll
                for (int m = 0; m < 4; ++m)
#pragma unroll
                    for (int n = 0; n < 2; ++n) acc[a][b][m][n] = (f32x4){0.f, 0.f, 0.f, 0.f};
        cur = nxt; cA = nA; cB = nB; ++ui;
        if constexpr (ALIGN_EPI) { if (wr == 1) PG8_BAR; }
    }
    PG8_WAIT_V(0);
    if constexpr (!ALIGN_EPI) { if (wr == 0) PG8_BAR; }
    PG8_BAR;
    if constexpr (Epi::AFTER_DRAIN) { E.fused(acc, cur, wr, wc, fr, fq, lds, wid, lane); S.done(cur); }
#undef PG8_SA
#undef PG8_SB
#undef PG8_STAGE
#undef PG8_LDA
#undef PG8_LDB
#undef PG8_MMA
#undef PG8_WAIT_V
#undef PG8_WAIT_L
#undef PG8_BAR
#undef PG8_SCHED
}
}
constexpr int NB = 16, SEQ = 2048, D = 1024, M = NB * SEQ, FF = 2816, NIN = 2048, DEPTH = 2;
constexpr int NWAVES = 8;
constexpr size_t MiB = 1u << 20;
constexpr size_t WS_PCNT = 1 * MiB + 64 * 1024;
constexpr size_t WS_BAR = 1 * MiB;
constexpr size_t WS_SSQ = 0;
constexpr size_t WS_W = 2 * MiB, W_LAYER = 39 * MiB;
constexpr size_t WO_GU1 = 0, WO_D1 = 11 * MiB, WO_IN = 16 * MiB + MiB / 2, WO_OUT = 20 * MiB + MiB / 2, WO_GU2 = 22 * MiB + MiB / 2, WO_D2 = 33 * MiB + MiB / 2;
constexpr size_t WS_XB = 80 * MiB;
constexpr size_t WS_H = 144 * MiB;
constexpr size_t WS_P = 320 * MiB, WS_VT = 352 * MiB, WS_CAT = 384 * MiB, WS_END = 448 * MiB;
constexpr size_t WS_GBAR = 1 * MiB + 16 * 1024;
constexpr size_t QK_BSTRIDE = 4194304, QK_KOFF = 1048576;
constexpr unsigned STAGGER_TICKS = 0;
static_assert(WS_H + (size_t)M * FF * 2 <= WS_P && WS_W + 2 * W_LAYER <= WS_XB, "d_ws map");
constexpr int LDS_BYTES = 150272;
constexpr int MISC_OFF = 150016;

#define GAS __attribute__((address_space(1)))
#define LAS __attribute__((address_space(3)))
typedef unsigned short bf16;
typedef unsigned v4u __attribute__((ext_vector_type(4)));
typedef unsigned v2u __attribute__((ext_vector_type(2)));
typedef float f32x4 __attribute__((ext_vector_type(4)));
typedef short bf16x8 __attribute__((ext_vector_type(8)));
#define LDS_WAIT() asm volatile("s_waitcnt lgkmcnt(0)" ::: "memory")
__device__ __forceinline__ unsigned f2bf(float f) { unsigned u = __builtin_bit_cast(unsigned, f); return (u + 0x7fffu + ((u >> 16) & 1u)) >> 16; }
typedef float f32x2_pk __attribute__((ext_vector_type(2))); typedef __bf16 bf16x2_pk __attribute__((ext_vector_type(2)));
__device__ __forceinline__ unsigned pk2(float lo, float hi) { const f32x2_pk v = {lo, hi}; return __builtin_bit_cast(unsigned, __builtin_convertvector(v, bf16x2_pk)); }
__device__ __forceinline__ float bflo(unsigned w) { return __builtin_bit_cast(float, w << 16); }
__device__ __forceinline__ float bfhi(unsigned w) { return __builtin_bit_cast(float, w & 0xffff0000u); }
__device__ __forceinline__ float wave_sum(float v) {
#pragma unroll
    for (int o = 1; o < 64; o <<= 1) v += __shfl_xor(v, o);
    return v;
}

#define XB_TMO      128
#define XB_XCNT(j)  (256  + 64 * (j))
#define XB_XSUB(j)  (1280 + 64 * (j))
#define XB_XGEN(j)  (2304 + 64 * (j))
#define XB_TOP      3328
#define XB_TOPGEN   3392
#define XCD_BAR_WORDS 3456
#define XB_GX(k)    (5120 + 64 * (k))
#define XB_ALL_WORDS 13312
#define XB_SPIN_CAP (1u << 18)

__device__ __forceinline__ unsigned xb_ld(unsigned* p)              { return __hip_atomic_load(p, __ATOMIC_RELAXED, __HIP_MEMORY_SCOPE_AGENT); }
__device__ __forceinline__ unsigned xb_add(unsigned* p, unsigned v) { return __hip_atomic_fetch_add(p, v, __ATOMIC_RELAXED, __HIP_MEMORY_SCOPE_AGENT); }
__device__ __forceinline__ unsigned xb_xcc_id() { return (unsigned)__builtin_amdgcn_s_getreg((3 << 11) | 20) & 0xFu; }
#define XB_SPIN(cond, bar) do { unsigned _sp = 0; while (cond) { __builtin_amdgcn_s_sleep(1); \
    if ((++_sp & 255u) == 0u) { if (xb_ld(&(bar)[XB_TMO])) break; if (_sp > XB_SPIN_CAP) { atomicAdd(&(bar)[XB_TMO], 1u); break; } } } } while (0)

struct XcdBarrier {
    unsigned* bar; unsigned x;
    volatile LAS unsigned* st;
};

__device__ __forceinline__ XcdBarrier xcd_barrier_post(unsigned* bar, volatile LAS unsigned* st) {
    XcdBarrier b; b.bar = bar; b.x = xb_xcc_id(); b.st = st;
    if (threadIdx.x == 0) { (void)xb_add(&bar[XB_XCNT(b.x)], 1u); (void)xb_add(&bar[XB_GX(b.x * 8u + (blockIdx.x & 7u))], 1u); }
    return b;
}
__device__ __forceinline__ void xcd_barrier_complete(unsigned* bar, unsigned x, unsigned& nloc, unsigned& nx) {
    const unsigned G = gridDim.x * gridDim.y * gridDim.z;
    unsigned sum, cnt, mine, sp = 0u;
    for (;;) {
        sum = 0u; cnt = 0u; mine = 0u;
#pragma unroll
        for (unsigned j = 0; j < 16; ++j) { const unsigned c = xb_ld(&bar[XB_XCNT(j)]); sum += c; cnt += (c > 0u) ? 1u : 0u; mine = (j == x) ? c : mine; }
        if (sum == G) break;
        __builtin_amdgcn_s_sleep(1);
        if ((++sp & 255u) == 0u) { if (xb_ld(&bar[XB_TMO])) break; if (sp > XB_SPIN_CAP) { atomicAdd(&bar[XB_TMO], 1u); break; } }
    }
    nloc = mine > 0u ? mine : 1u; nx = cnt > 0u ? cnt : 1u;
}

__device__ __forceinline__ void xcd_barrier(const XcdBarrier& b, bool local = false) {
    asm volatile("s_waitcnt vmcnt(0)" ::: "memory");
    __syncthreads();
    if (threadIdx.x == 0) {
        unsigned* bar = b.bar;
        __builtin_amdgcn_s_waitcnt(0);
        unsigned nloc = b.st[0], nx = b.st[1];
        if (nloc == 0u) { xcd_barrier_complete(bar, b.x, nloc, nx); b.st[0] = nloc; b.st[1] = nx; }
        const unsigned old = xb_add(&bar[XB_XSUB(b.x)], 1u);
        const unsigned gen = old / nloc;
        if (old + 1u == (gen + 1u) * nloc) {
            __builtin_amdgcn_fence(__ATOMIC_RELEASE, "agent");
            asm volatile("s_waitcnt vmcnt(0)" ::: "memory");
            if (!local) {
            const unsigned og = xb_add(&bar[XB_TOP], 1u);
            const unsigned tg = og / nx;
            if (og + 1u == (tg + 1u) * nx) xb_add(&bar[XB_TOPGEN], 1u);
            else XB_SPIN(xb_ld(&bar[XB_TOPGEN]) == tg, bar);
            }
            __builtin_amdgcn_fence(__ATOMIC_ACQUIRE, "agent");
            xb_add(&bar[XB_XGEN(b.x)], 1u);
            asm volatile("s_waitcnt vmcnt(0)" ::: "memory");
        } else {
            XB_SPIN(xb_ld(&bar[XB_XGEN(b.x)]) == gen, bar);
            __builtin_amdgcn_fence(__ATOMIC_ACQUIRE, "agent");
            asm volatile("s_waitcnt vmcnt(0)" ::: "memory");
        }
    }
    __syncthreads();
}


__device__ __forceinline__ void grp_barrier(unsigned* cnt, volatile LAS unsigned* seqw) {
    asm volatile("s_waitcnt vmcnt(0)" ::: "memory");
    __syncthreads();
    if (threadIdx.x == 0) {
        __builtin_amdgcn_fence(__ATOMIC_RELEASE, "agent"); asm volatile("s_waitcnt vmcnt(0)" ::: "memory");
        const unsigned want = 32u * (seqw[0] + 1u); seqw[0] = seqw[0] + 1u;
        (void)xb_add(cnt, 1u);
        unsigned sp = 0u;
        while (xb_ld(cnt) < want) { __builtin_amdgcn_s_sleep(1); if (++sp > (1u << 22)) break; }
        __builtin_amdgcn_fence(__ATOMIC_ACQUIRE, "agent"); asm volatile("s_waitcnt vmcnt(0)" ::: "memory");
    }
    __syncthreads();
}

typedef float f32x2 __attribute__((ext_vector_type(2)));
__device__ __forceinline__ void transpose_item(const float* W, int ldw, const float* gain, bf16* WT, int ldt, int k0, int n0, int drow0, int lane) {
    const float* src = W + (size_t)k0 * ldw + n0 + 2 * lane;
    bf16* d0 = WT + (size_t)(drow0 + 2 * lane) * ldt + k0;
    f32x2 v[64];
#pragma unroll
    for (int kk = 0; kk < 64; ++kk) v[kk] = *(const f32x2*)(src + (size_t)kk * ldw);
    const float gl = gain ? gain[k0 + lane] : 1.0f;
#pragma unroll
    for (int col = 0; col < 2; ++col) {
#pragma unroll
        for (int c = 0; c < 8; ++c) {
            float e[8];
#pragma unroll
            for (int kk = 0; kk < 8; ++kk) { const float gk = __builtin_bit_cast(float, __builtin_amdgcn_readlane(__builtin_bit_cast(int, gl), 8 * c + kk)); e[kk] = (col ? v[8 * c + kk].y : v[8 * c + kk].x) * gk; }
            v4u o; o.x = pk2(e[0], e[1]); o.y = pk2(e[2], e[3]); o.z = pk2(e[4], e[5]); o.w = pk2(e[6], e[7]);
            *(v4u*)(d0 + (size_t)col * ldt + 8 * c) = o;
        }
    }
}
struct LayerW { const float *n1, *g1, *u1, *d1, *nm, *win, *rpb, *wpool, *pscale, *wout, *n2, *g2, *u2, *d2; bf16 *GU1, *D1, *WIN, *WOUT, *GU2, *D2; };
__device__ __forceinline__ LayerW layer_w(const float* const* in, unsigned char* ws, int l) {
    LayerW w;
    w.n1 = in[1] + (size_t)l * D; w.g1 = in[2] + (size_t)l * D * FF; w.u1 = in[3] + (size_t)l * D * FF; w.d1 = in[4] + (size_t)l * FF * D;
    w.nm = in[5] + (size_t)l * D; w.win = in[6] + (size_t)l * D * NIN; w.rpb = in[7] + (size_t)l * 8 * 15 * 31; w.wpool = in[8] + (size_t)l * 4 * 128 * 128;
    w.pscale = in[9] + (size_t)l * 512; w.wout = in[10] + (size_t)l * D * D; w.n2 = in[11] + (size_t)l * D;
    w.g2 = in[12] + (size_t)l * D * FF; w.u2 = in[13] + (size_t)l * D * FF; w.d2 = in[14] + (size_t)l * FF * D;
    unsigned char* b = ws + WS_W + (size_t)l * W_LAYER;
    w.GU1 = (bf16*)(b + WO_GU1); w.D1 = (bf16*)(b + WO_D1); w.WIN = (bf16*)(b + WO_IN); w.WOUT = (bf16*)(b + WO_OUT); w.GU2 = (bf16*)(b + WO_GU2); w.D2 = (bf16*)(b + WO_D2);
    return w;
}
__device__ __forceinline__ void prologue(const float* const* in, unsigned char* ws, int gw, int NGW, int lane, int part) {
    constexpr int I_GU = (D / 64) * (FF / 128), I_DN = (FF / 64) * (D / 128), I_IN = (D / 64) * (NIN / 128), I_OUT = (512 / 64) * (D / 128), I_FOLD = 4 * 16 * 16;
    constexpr int I_LAYER = 4 * I_GU + 2 * I_DN + I_IN + I_OUT + I_FOLD;
    if (part & 1)
    for (int it = gw; it < DEPTH * I_LAYER; it += NGW) {
        const int l = it / I_LAYER; int r = it % I_LAYER; const LayerW w = layer_w(in, ws, l);
        if (r < 4 * I_GU) {
            const int which = r / I_GU; r %= I_GU; const int nkb = D / 64, kb = r % nkb, nb = r / nkb;
            const float* W = which == 0 ? w.g1 : which == 1 ? w.u1 : which == 2 ? w.g2 : w.u2; const float* gn = which < 2 ? w.n1 : w.n2; bf16* T = which < 2 ? w.GU1 : w.GU2;
            transpose_item(W, FF, gn, T, D, 64 * kb, 128 * nb, nb * 256 + (which & 1) * 128, lane); continue; }
        r -= 4 * I_GU;
        if (r < 2 * I_DN) { const int which = r / I_DN; r %= I_DN; const int nkb = FF / 64, kb = r % nkb, nb = r / nkb;
            transpose_item(which ? w.d2 : w.d1, D, nullptr, which ? w.D2 : w.D1, FF, 64 * kb, 128 * nb, 128 * nb, lane); continue; }
        r -= 2 * I_DN;
        if (r < I_IN) { const int nkb = D / 64, kb = r % nkb, nb = r / nkb; const int n0 = 128 * nb; transpose_item(w.win, NIN, w.nm, w.WIN, D, 64 * kb, n0, n0 < 1024 ? n0 : (n0 < 1536 ? n0 + 512 : n0 - 512), lane); continue; }
        r -= I_IN;
        if (r < I_OUT) { const int nkb = 512 / 64, kb = r % nkb, nb = r / nkb; transpose_item(w.wout, D, nullptr, w.WOUT, D, 64 * kb, 128 * nb, 128 * nb, lane); continue; }
        r -= I_OUT;
        {
            const int g = r >> 8, nb = (r >> 4) & 15, cb = r & 15, n = 64 * nb + lane;
            const float* wp = w.wpool + ((size_t)g * 128 + 8 * cb) * 128; const float* sc = w.pscale + 128 * g; const float* wo = w.wout + (size_t)(512 + 128 * g) * D + n;
            float wr_[8][2], sr_[2];
#pragma unroll
            for (int hh = 0; hh < 2; ++hh) { sr_[hh] = sc[64 * hh + lane];
#pragma unroll
                for (int c = 0; c < 8; ++c) wr_[c][hh] = wp[c * 128 + 64 * hh + lane]; }
#pragma unroll
            for (int hh = 0; hh < 2; ++hh)
#pragma unroll
                for (int c = 0; c < 8; ++c) wr_[c][hh] *= sr_[hh];
            float a[8];
#pragma unroll
            for (int c = 0; c < 8; ++c) a[c] = 0.f;
#pragma unroll
            for (int hh = 0; hh < 2; ++hh)
#pragma unroll
                for (int q = 0; q < 2; ++q) {
                    float x[32];
#pragma unroll
                    for (int dd = 0; dd < 32; ++dd) x[dd] = wo[(size_t)(64 * hh + 32 * q + dd) * D];
#pragma unroll
                    for (int dd = 0; dd < 32; ++dd)
#pragma unroll
                        for (int c = 0; c < 8; ++c) a[c] += __builtin_bit_cast(float, __builtin_amdgcn_readlane(__builtin_bit_cast(int, wr_[c][hh]), 32 * q + dd)) * x[dd];
                }
            v4u o; o.x = pk2(a[0], a[1]); o.y = pk2(a[2], a[3]); o.z = pk2(a[4], a[5]); o.w = pk2(a[6], a[7]);
            *(v4u*)(w.WOUT + (size_t)n * D + 512 + 128 * g + 8 * cb) = o;
        }
    }
    if (!(part & 2)) return;
    const float* x = in[0]; bf16* XB = (bf16*)(ws + WS_XB); float* ssq = (float*)(ws + WS_SSQ);
    for (int m = gw; m < M; m += NGW) {
        const f32x4* xr = (const f32x4*)(x + (size_t)m * D) + lane; f32x4 v[4]; float s = 0.f;
#pragma unroll
        for (int j = 0; j < 4; ++j) { v[j] = xr[64 * j]; s += (v[j].x * v[j].x + v[j].y * v[j].y) + (v[j].z * v[j].z + v[j].w * v[j].w); }
        s = wave_sum(s);
        v2u* o8 = (v2u*)(XB + (size_t)m * D) + lane;
#pragma unroll
        for (int j = 0; j < 4; ++j) { v2u o; o.x = pk2(v[j].x, v[j].y); o.y = pk2(v[j].z, v[j].w); o8[64 * j] = o; }
        if (lane == 0) ssq[m] = s;
    }
    for (int i = gw * 64 + lane; i < 6 * M; i += NGW * 64) ssq[M + i] = 0.f;
    { unsigned* pc = (unsigned*)(ws + WS_PCNT); for (int i = gw * 64 + lane; i < 128 * 64; i += NGW * 64) pc[i] = 0u; }
}

__device__ __forceinline__ void acc8(float (&s)[8], const v4u v, const float sg) {
    s[0] += sg * bflo(v.x); s[1] += sg * bfhi(v.x); s[2] += sg * bflo(v.y); s[3] += sg * bfhi(v.y); s[4] += sg * bflo(v.z); s[5] += sg * bfhi(v.z); s[6] += sg * bflo(v.w); s[7] += sg * bfhi(v.w);
}
template <int W2> __device__ __forceinline__ void pool_block(const bf16* P, bf16* CAT, int tb, int g, int lane) {
    constexpr int W = 2 * W2, R = W + 15;
    const int q = lane >> 4, c8 = 8 * (lane & 15), row0 = 64 * tb + 16 * q, t0 = row0 & (SEQ - 1);
    const bf16* pb = P + (size_t)(row0 - t0) * 512 + g * 128 + c8;
    v4u r[R];
#pragma unroll
    for (int k = 0; k < R; ++k) { const int t = t0 - W2 + k, tc = min(max(t, 0), SEQ - 1);
        v4u v = *(const v4u*)(pb + (size_t)tc * 512);
        r[k] = v; }
    __builtin_amdgcn_sched_barrier(0);
#pragma unroll
    for (int k = 0; k < R; ++k) { const int t = t0 - W2 + k; if (t < 0 || t >= SEQ) r[k] = (v4u){0u, 0u, 0u, 0u}; }
    float s[8];
#pragma unroll
    for (int e = 0; e < 8; ++e) s[e] = 0.f;
#pragma unroll
    for (int k = 0; k < W; ++k) acc8(s, r[k], 1.0f);
    bf16* ob = CAT + (size_t)row0 * 1024 + 512 + g * 128 + c8;
#pragma unroll
    for (int i = 0; i < 16; ++i) {
        const int t = t0 + i, cnt = min(t + W2, SEQ) - max(t - W2, 0); const float ic = 1.0f / (float)cnt; const v4u cv = r[i + W2];
        v4u o; o.x = pg8::cvt_pk_bf16(s[0] * ic - bflo(cv.x), s[1] * ic - bfhi(cv.x)); o.y = pg8::cvt_pk_bf16(s[2] * ic - bflo(cv.y), s[3] * ic - bfhi(cv.y));
        o.z = pg8::cvt_pk_bf16(s[4] * ic - bflo(cv.z), s[5] * ic - bfhi(cv.z)); o.w = pg8::cvt_pk_bf16(s[6] * ic - bflo(cv.w), s[7] * ic - bfhi(cv.w));
        *(v4u*)(ob + (size_t)i * 1024) = o;
        if (i < 15) { acc8(s, r[i + W], 1.0f); acc8(s, r[i], -1.0f); }
    }
}
constexpr int AT_SLOT = 16384, AT_NSLOT = 9, AT_TBL_OFF = AT_NSLOT * AT_SLOT + 256;
__device__ __forceinline__ int at_rs(int r) { return min(max(r - 4, 0), 24); }
__device__ __forceinline__ void attn_pool_phase(LAS unsigned char* lds, const bf16* Q, const bf16* K, const bf16* VT, const bf16* P, bf16* CAT, const float* rpb,
                                                int vcu, int G, int wave, int lane, int tid, int probe_mask = 3) {
    LAS float* tbl = (LAS float*)(lds + AT_TBL_OFF);
    const int j = wave & 3, rsub = wave >> 2, ql = lane & 15, quad = lane >> 4;
    const int c = 16 * j + ql, cs = min(max(c - 8, 0), 48), kc0 = min(max(16 * j - 8, 0), 32);
    const int dcb = kc0 + 4 * quad - c + 15;
    bool sel1[4];
#pragma unroll
    for (int i = 0; i < 4; ++i) sel1[i] = (4 * quad + i) < (cs - kc0);
    const int koff = (quad * 64 + kc0 + ql) * 16;
    const int voff = 8192 + ((kc0 >> 2) + quad) * 512 + ql * 8;
    if (probe_mask & 1)
    for (int wi = vcu; wi < 256; wi += G) {
        const int b = wi >> 4, g = wi & 15, h = g >> 1, half = g & 1, r0 = 16 * half;
        const size_t rowblk0 = (size_t)(b * 8 + h) * 32;
        const bf16* Qb = Q + (size_t)b * QK_BSTRIDE + (size_t)h * 32 * 4096; const bf16* Kb = Qb + QK_KOFF;
        __syncthreads();
        int cur_hi = at_rs(r0 + 1) + 7;
        {
            const int lo = at_rs(r0);
            v4u t[9][2];
#pragma unroll
            for (int q = 0; q < 9; ++q) { const int rw = min(lo + q, cur_hi);
                t[q][0] = *(const v4u*)(Kb + (size_t)rw * 4096 + tid * 8); t[q][1] = *(const v4u*)(VT + (rowblk0 + rw) * 4096 + tid * 8); }
            const float tv = tid < 465 ? rpb[h * 465 + tid] : 0.f;
            __builtin_amdgcn_sched_barrier(0);
            if (tid < 465) tbl[tid] = tv * 1.4426950408889634f;
#pragma unroll
            for (int q = 0; q < 9; ++q) { const int rw = min(lo + q, cur_hi); LAS unsigned char* d = lds + (rw % AT_NSLOT) * AT_SLOT + tid * 16;
                *(LAS v4u*)d = t[q][0]; *(LAS v4u*)(d + 8192) = t[q][1]; }
        }
        bf16x8 qf[2];
#pragma unroll
        for (int ks = 0; ks < 2; ++ks) qf[ks] = *(const bf16x8*)(Qb + ((size_t)(r0 + rsub) * 8 + ks * 4 + quad) * 512 + c * 8);
        __syncthreads();
#pragma unroll 1
        for (int it = 0; it < 8; ++it) {
            const int ra = r0 + 2 * it, r = ra + rsub, rs = at_rs(r);
            const int nxt_hi = it < 7 ? at_rs(ra + 3) + 7 : cur_hi;
            v4u pre[2][2]; bf16x8 qn[2];
#pragma unroll
            for (int q = 0; q < 2; ++q) { const int rw = min(cur_hi + 1 + q, 31);
                pre[q][0] = *(const v4u*)(Kb + (size_t)rw * 4096 + tid * 8); pre[q][1] = *(const v4u*)(VT + (rowblk0 + rw) * 4096 + tid * 8); }
            { const int rn = min(r + 2, 31);
#pragma unroll
              for (int ks = 0; ks < 2; ++ks) qn[ks] = *(const bf16x8*)(Qb + ((size_t)rn * 8 + ks * 4 + quad) * 512 + c * 8); }
            const size_t tokq = (size_t)b * SEQ + r * 64 + c;
            f32x4 S[16];
            int sl = rs % AT_NSLOT;
#pragma unroll
            for (int s = 0; s < 8; ++s) {
                const LAS unsigned char* kp = lds + sl * AT_SLOT + koff;
#pragma unroll
                for (int h2 = 0; h2 < 2; ++h2) {
                    const bf16x8 k0 = *(const LAS bf16x8*)(kp + h2 * 256), k1 = *(const LAS bf16x8*)(kp + 4096 + h2 * 256);
                    f32x4 a = (f32x4){0.f, 0.f, 0.f, 0.f};
                    a = __builtin_amdgcn_mfma_f32_16x16x32_bf16(k0, qf[0], a, 0, 0, 0);
                    a = __builtin_amdgcn_mfma_f32_16x16x32_bf16(k1, qf[1], a, 0, 0, 0);
                    S[2 * s + h2] = a;
                }
                sl = sl + 1 == AT_NSLOT ? 0 : sl + 1;
            }
            float xs[8][4]; float mx = -1e30f;
            const LAS float* tb = tbl + (rs - r + 7) * 31 + dcb;
#pragma unroll
            for (int i = 0; i < 4; ++i) {
                const LAS float* tbi = tb + i + (sel1[i] ? 16 : 0);
#pragma unroll
                for (int s = 0; s < 8; ++s) { const float x = (sel1[i] ? S[2 * s + 1][i] : S[2 * s][i]) + tbi[s * 31]; xs[s][i] = x; mx = fmaxf(mx, x); }
            }
            mx = fmaxf(mx, __shfl_xor(mx, 16)); mx = fmaxf(mx, __shfl_xor(mx, 32));
            float sum = 0.f;
#pragma unroll
            for (int s = 0; s < 8; ++s)
#pragma unroll
                for (int i = 0; i < 4; ++i) { const float p = __builtin_amdgcn_exp2f(xs[s][i] - mx); sum += p; S[2 * s][i] = sel1[i] ? 0.f : p; S[2 * s + 1][i] = sel1[i] ? p : 0.f; }
            sum += __shfl_xor(sum, 16); sum += __shfl_xor(sum, 32);
            const float inv = 1.0f / sum;
            f32x4 O[4];
#pragma unroll
            for (int db = 0; db < 4; ++db) O[db] = (f32x4){0.f, 0.f, 0.f, 0.f};
            sl = rs % AT_NSLOT;
#pragma unroll
            for (int s = 0; s < 8; ++s) {
                v4u pw; pw.x = pg8::cvt_pk_bf16(S[2 * s][0], S[2 * s][1]); pw.y = pg8::cvt_pk_bf16(S[2 * s][2], S[2 * s][3]);
                pw.z = pg8::cvt_pk_bf16(S[2 * s + 1][0], S[2 * s + 1][1]); pw.w = pg8::cvt_pk_bf16(S[2 * s + 1][2], S[2 * s + 1][3]);
                const bf16x8 pb = __builtin_bit_cast(bf16x8, pw);
                const LAS unsigned char* vp = lds + sl * AT_SLOT + voff;
#pragma unroll
                for (int db = 0; db < 4; ++db) {
                    const int o = (db ^ (quad & 1)) * 128;
                    const v2u lo = *(const LAS v2u*)(vp + o), hi = *(const LAS v2u*)(vp + o + 2048);
                    O[db] = __builtin_amdgcn_mfma_f32_16x16x32_bf16(__builtin_bit_cast(bf16x8, (v4u){lo.x, lo.y, hi.x, hi.y}), pb, O[db], 0, 0, 0);
                }
                sl = sl + 1 == AT_NSLOT ? 0 : sl + 1;
            }
            bf16* op = CAT + tokq * 1024 + h * 64 + 4 * quad;
#pragma unroll
            for (int db = 0; db < 4; ++db) { v2u o; o.x = pg8::cvt_pk_bf16(O[db][0] * inv, O[db][1] * inv); o.y = pg8::cvt_pk_bf16(O[db][2] * inv, O[db][3] * inv); *(v2u*)(op + 16 * db) = o; }
            __syncthreads();
#pragma unroll
            for (int q = 0; q < 2; ++q) { const int rw = cur_hi + 1 + q;
                if (rw <= nxt_hi) { LAS unsigned char* d = lds + (rw % AT_NSLOT) * AT_SLOT + tid * 16; *(LAS v4u*)d = pre[q][0]; *(LAS v4u*)(d + 8192) = pre[q][1]; } }
            cur_hi = nxt_hi; qf[0] = qn[0]; qf[1] = qn[1];
            __syncthreads();
        }
    }
    const int gw = vcu * NWAVES + wave, NGW = G * NWAVES;
    if (probe_mask & 2)
    for (int wb = gw; wb < (M / 64) * 4; wb += NGW) {
        const int g = wb & 3, tb = wb >> 2;
        if (g == 0) pool_block<1>(P, CAT, tb, g, lane); else if (g == 1) pool_block<2>(P, CAT, tb, g, lane); else if (g == 2) pool_block<4>(P, CAT, tb, g, lane); else pool_block<8>(P, CAT, tb, g, lane);
    }
    __syncthreads();
}

struct Args { const float* in[16]; float* out; unsigned char* ws; };
__global__ void __launch_bounds__(NWAVES * 64, 2) mega_fwd(Args args) {
    extern __shared__ __attribute__((aligned(16))) unsigned char lds_raw[];
    cg::grid_group grid = cg::this_grid();
    LAS unsigned char* lds = (LAS unsigned char*)lds_raw;
    const int tid = threadIdx.x, lane = tid & 63, wave = __builtin_amdgcn_readfirstlane(tid >> 6);
    const int G = gridDim.x, bx = blockIdx.x, vcu = (G % 8 == 0) ? (bx % 8) * (G / 8) + bx / 8 : bx;
    const int gw = vcu * NWAVES + wave, NGW = G * NWAVES;
    unsigned char* ws = args.ws;
    float* ssq = (float*)(ws + WS_SSQ); bf16* XB = (bf16*)(ws + WS_XB); bf16* HB = (bf16*)(ws + WS_H);
    bf16 *QB = (bf16*)args.out, *KB = (bf16*)args.out + QK_KOFF, *PB = (bf16*)(ws + WS_P), *VT = (bf16*)(ws + WS_VT), *CAT = (bf16*)(ws + WS_CAT);
    float* xo = args.out;

    if (tid < 64) ((LAS unsigned*)(lds + MISC_OFF))[tid] = 0u;
    unsigned* barw = (unsigned*)(ws + WS_BAR);
    if (bx == 0) for (int i = tid; i < XB_ALL_WORDS; i += NWAVES * 64) barw[i] = 0u;
    if (bx == 0 && tid < 8 * 64) ((unsigned*)(ws + WS_GBAR))[tid] = 0u;
    grid.sync();
    const XcdBarrier bar = xcd_barrier_post(barw, (volatile LAS unsigned*)(lds + MISC_OFF));
#pragma unroll 1
    for (int rep = 0; rep < 1 + (DUP_PRO ? 2 : 0); ++rep) {
        int pr = rep ? DUP_PRO : 3; asm volatile("" : "+s"(pr));
        prologue(args.in, ws, gw, NGW, lane, pr);
        xcd_barrier(bar);
    }
    volatile LAS unsigned* const lmw = (volatile LAS unsigned*)(lds + MISC_OFF) + 17;
    if (tid == 0) {
        unsigned ok = (G == 256) ? 1u : 0u;
        for (unsigned j = 0; j < 16u && ok; ++j) { const unsigned c = xb_ld(&barw[XB_XCNT(j)]); if (c == 0u) continue; if (c != 32u) { ok = 0u; break; }
            unsigned whole = 0u; for (unsigned g = 0; g < 8u; ++g) whole |= (xb_ld(&barw[XB_GX(j * 8u + g)]) == 32u) ? 1u : 0u; if (!whole) ok = 0u; }
        lmw[0] = ok;
    }
    __syncthreads();
    const bool lm = lmw[0] != 0u;
#define GRID_SYNC() xcd_barrier(bar, lm)
#define LAUNDER_L() int ll = l; asm volatile("" : "+s"(ll)); const LayerW w = layer_w(args.in, ws, ll)
#pragma unroll 1
    for (int l = 0; l < DEPTH; ++l) {
        {
            LAUNDER_L();
            pg8::Gemm g{XB, w.GU1, M, 2 * FF, D}; pg8::StaticOrder S; S.init(M, 2 * FF, G, bx);
            pg8::EpiSwiglu E{HB, ssq + (size_t)(3 * ll) * M, FF};
            pg8::gemm_phase<pg8::EpiSwiglu, pg8::StaticOrder, true, true>(lds, g, S, E);
#if DUP_UP
            GRID_SYNC();
            pg8::gemm_phase<pg8::EpiSwiglu, pg8::StaticOrder, true, true>(lds, g, S, E);
#endif
        }
        GRID_SYNC();
#pragma unroll 1
        for (int rep = 0; rep < 1 + DUP_DOWN; ++rep) {
            LAUNDER_L();
            if (rep) GRID_SYNC();
            pg8::Gemm g{HB, w.D1, M, D, FF}; pg8::StaticOrder S; S.init(M, D, G, bx);
#if DUP_DOWN_NULL
            if (rep) { pg8::EpiNull EN{(float*)(ws + WS_END)}; pg8::gemm_phase<pg8::EpiNull, pg8::StaticOrder, true, true>(lds, g, S, EN); continue; }
#endif
            pg8::EpiRes E{XB, rep ? (float*)(ws + WS_END) : ssq + (size_t)(3 * ll + 1) * M, rep ? 0.0f : 0.5f};
            pg8::gemm_phase<pg8::EpiRes, pg8::StaticOrder, true, true>(lds, g, S, E);
        }
        GRID_SYNC();
#pragma unroll 1
        for (int rep = 0; rep < 1 + DUP_IN; ++rep) {
            LAUNDER_L();
            if (rep) GRID_SYNC();
            {
                pg8::Gemm g{XB, w.WIN, M, 1536, D}; pg8::WinOrder S; S.init(M, G, bx);
                pg8::EpiZV E{pg8::EpiZ{QB, PB, ssq + (size_t)(3 * ll + 1) * M, QK_KOFF, QK_BSTRIDE}, pg8::EpiVT{VT, ssq + (size_t)(3 * ll + 1) * M}};
                pg8::gemm_phase<pg8::EpiZV, pg8::WinOrder, true, true>(lds, g, S, E);
            }
        }
        GRID_SYNC();
#pragma unroll 1
        for (int rep = 0; rep < 1 + DUP_ATTN; ++rep) {
            LAUNDER_L();
            int t2 = threadIdx.x; asm volatile("" : "+v"(t2));
            if (rep) GRID_SYNC();
            int pm_ = rep ? ATT_PROBE_MASK : 3; asm volatile("" : "+s"(pm_));
            attn_pool_phase(lds, QB, KB, VT, PB, CAT, w.rpb, vcu, G, __builtin_amdgcn_readfirstlane(t2 >> 6), t2 & 63, t2, pm_);
        }
        GRID_SYNC();
#pragma unroll 1
        for (int rep = 0; rep < 1 + DUP_WOUT; ++rep) {
            LAUNDER_L();
            if (rep) GRID_SYNC();
            pg8::Gemm g{CAT, w.WOUT, M, D, D}; pg8::StaticOrder S; S.init(M, D, G, bx);
            pg8::EpiRes E{XB, rep ? (float*)(ws + WS_END) : ssq + (size_t)(3 * ll + 2) * M, rep ? 0.0f : 1.0f};
            pg8::gemm_phase<pg8::EpiRes, pg8::StaticOrder, true, true>(lds, g, S, E);
        }
        GRID_SYNC();
        {
            LAUNDER_L();
            pg8::Gemm g{XB, w.GU2, M, 2 * FF, D}; pg8::StaticOrder S; S.init(M, 2 * FF, G, bx);
            pg8::EpiSwiglu E{HB, ssq + (size_t)(3 * ll + 2) * M, FF};
            pg8::gemm_phase<pg8::EpiSwiglu, pg8::StaticOrder, true, true>(lds, g, S, E);
        }
        GRID_SYNC();
        {
            LAUNDER_L();
            pg8::Gemm g{HB, w.D2, M, D, FF}; pg8::StaticOrder S; S.init(M, D, G, bx);
            if (ll == DEPTH - 1 && G == 256) {
                pg8::EpiResFinal EF{XB, ssq + (size_t)(3 * DEPTH) * M, (unsigned*)(ws + WS_PCNT), args.in[15], xo, 0.5f};
                pg8::gemm_phase<pg8::EpiResFinal, pg8::StaticOrder, true, true>(lds, g, S, EF);
            } else {
                pg8::EpiRes E{XB, ssq + (size_t)(3 * ll + 3) * M, 0.5f};
                pg8::gemm_phase<pg8::EpiRes, pg8::StaticOrder, true, true>(lds, g, S, E);
                GRID_SYNC();
            }
        }
    }
    if (G != 256) {
        int t2 = threadIdx.x; asm volatile("" : "+v"(t2)); const int ln = t2 & 63, gwf = vcu * NWAVES + __builtin_amdgcn_readfirstlane(t2 >> 6);
        const float* gn = args.in[15]; const float* sf = ssq + (size_t)(3 * DEPTH) * M;
        for (int m = gwf; m < M; m += NGW) {
            const float rs = pg8::rstd_of(sf[m]); f32x4* xr = (f32x4*)(xo + (size_t)m * D) + ln; const f32x4* gr = (const f32x4*)gn + ln;
            const v2u* hr = (const v2u*)(XB + (size_t)m * D) + ln;
#pragma unroll
            for (int jj = 0; jj < 4; ++jj) { const v2u hw = hr[64 * jj];
                const f32x4 v = (f32x4){bflo(hw.x), bfhi(hw.x), bflo(hw.y), bfhi(hw.y)};
                xr[64 * jj] = v * rs * gr[64 * jj]; }
        }
    }
}

extern "C" void kernel_launch(void* const* d_in, const int* in_sizes, int n_in, void* d_out, int out_size, void* d_ws, size_t ws_size, hipStream_t stream) {
    static int grid = 0;
    if (grid == 0) {
        if (n_in != 16 || in_sizes[0] != M * D || out_size != M * D || ws_size < WS_END) { fprintf(stderr, "kernel_launch: unexpected shapes (n_in %d, in0 %d, out %d, ws %zu)\n", n_in, n_in > 0 ? in_sizes[0] : -1, out_size, ws_size); grid = -1; return; }
        int dev = 0, cus = 0, per_cu = 0;
        if (hipGetDevice(&dev) != hipSuccess || hipDeviceGetAttribute(&cus, hipDeviceAttributeMultiprocessorCount, dev) != hipSuccess) { grid = -1; return; }
        if (hipFuncSetAttribute((const void*)mega_fwd, hipFuncAttributeMaxDynamicSharedMemorySize, LDS_BYTES) != hipSuccess) { fprintf(stderr, "kernel_launch: hipFuncSetAttribute failed\n"); grid = -1; return; }
        if (hipOccupancyMaxActiveBlocksPerMultiprocessor(&per_cu, (const void*)mega_fwd, NWAVES * 64, LDS_BYTES) != hipSuccess || per_cu < 1) { fprintf(stderr, "kernel_launch: occupancy query gave %d\n", per_cu); per_cu = 1; }
        (void)hipGetLastError();
        grid = cus * 1;
    }
    if (grid < 0) return;
    Args a{};
    for (int i = 0; i < 16; ++i) a.in[i] = (const float*)d_in[i];
    a.out = (float*)d_out; a.ws = (unsigned char*)d_ws;
    void* kargs[] = {&a};
    const hipError_t e = hipLaunchCooperativeKernel((const void*)mega_fwd, dim3(grid), dim3(NWAVES * 64), kargs, LDS_BYTES, stream);
    if (e != hipSuccess) fprintf(stderr, "kernel_launch: cooperative launch failed: %s (grid %d)\n", hipGetErrorString(e), grid);
}
```

```cpp
#include <hip/hip_runtime.h>
#include <hip/hip_cooperative_groups.h>
#include <cstdio>
#include <cstdint>
namespace cg = cooperative_groups;
#define DUP_PRO 0
#define DUP_UP 0
#define DUP_ATTN 0
#define DUP_DOWN 0
#define DUP_IN 0
#define DUP_WOUT 0
#define ATT_PROBE_MASK 3
#define DUP_DOWN_NULL 0
namespace pg8 {
#define PG8_LAS __attribute__((address_space(3)))
typedef unsigned short bf16_t;
typedef short bf16x8 __attribute__((ext_vector_type(8)));
typedef float f32x4 __attribute__((ext_vector_type(4)));
typedef unsigned u32x4 __attribute__((ext_vector_type(4)));
constexpr int BM = 256, BK = 64, HALF = 128, HTB = HALF * BK * 2  , STAGE_BYTES = 8 * HTB, NXCD = 8, WGM = 8;

__host__ __device__ __forceinline__ int lds_byte(int r, int c) { const int st = (r >> 4) * 2 + (c >> 5), rr = r & 15, cc = c & 31, ob = rr * 64 + cc * 2; return st * 1024 + (ob ^ (((ob >> 9) & 1) << 5)); }
__host__ __device__ __forceinline__ void stage_rc(int b, int& R, int& C) { const int st = b / 1024, sb = b % 1024, swz = sb ^ (((sb >> 9) & 1) << 5); R = (st >> 1) * 16 + swz / 64; C = (st & 1) * 32 + (swz % 64) / 2; }
__host__ __device__ __forceinline__ int perm32(int rho) { const int n = rho >> 4, i = rho & 15; return 8 * (i >> 2) + 4 * n + (i & 3); }

struct Unit { int pm, pn, swp; };
struct Gemm { const bf16_t* A; const bf16_t* Bt; int M, N, K; };

struct StaticOrder {
    int nM, nN, nwg, G, c;
    __host__ __device__ void init(int M, int N, int G_, int c_) { nM = M / BM; nN = N / BM; nwg = nM * nN; G = G_; c = c_; }
    __host__ __device__ bool next(int i, Unit& u) const {
        const long L = (long)i * G + c; if (L >= nwg) return false;
        int wgid = (int)L; { const int q = nwg / NXCD, r = nwg % NXCD, xcd = wgid % NXCD, off = wgid / NXCD; wgid = (xcd < r ? xcd * (q + 1) : r * (q + 1) + (xcd - r) * q) + off; }
        const int nig = WGM * nN, gid = wgid / nig, fm = gid * WGM, gsz = (nM - fm) < WGM ? (nM - fm) : WGM;
        u.pm = fm + ((wgid % nig) % gsz); u.pn = (wgid % nig) / gsz; u.swp = 0; return true;
    }
    __device__ __forceinline__ void a_ready(const Unit&) const {}
    __device__ __forceinline__ void done(const Unit&) const {}
};

typedef float f32x2_cv __attribute__((ext_vector_type(2))); typedef __bf16 bf16x2_cv __attribute__((ext_vector_type(2)));
__device__ __forceinline__ unsigned cvt_pk_bf16(float lo, float hi) { const f32x2_cv v = {lo, hi}; return __builtin_bit_cast(unsigned, __builtin_convertvector(v, bf16x2_cv)); }
typedef float f32x2 __attribute__((ext_vector_type(2)));
constexpr float RMS_EPS_C = 1e-6f;
__device__ __forceinline__ float rstd_of(float ss) { return __builtin_amdgcn_rsqf(ss * (1.0f / 1024.0f) + RMS_EPS_C); }
__device__ __forceinline__ float silu_mul(float g, float u) { return g * __builtin_amdgcn_rcpf(1.0f + __builtin_amdgcn_exp2f(g * -1.4426950408889634f)) * u; }

typedef float f32x2v __attribute__((ext_vector_type(2)));
struct EpiSwiglu {
    static constexpr bool PERM = true, AFTER_DRAIN = false;
    bf16_t* H; const float* ssq; int ldh;
    __device__ __forceinline__ void operator()(const f32x4 (&acc)[2][2][4][2], const Unit& u, int wr, int wc, int fr, int fq) const {
        const int row0 = u.pm * BM + wr * 64 + fr, col0 = u.pn * 128 + wc * 32 + 8 * fq;
        float rsv[2][4];
#pragma unroll
        for (int ai = 0; ai < 2; ++ai)
#pragma unroll
            for (int m = 0; m < 4; ++m) rsv[ai][m] = ssq[row0 + ai * HALF + m * 16];
        __builtin_amdgcn_sched_barrier(0);
#pragma unroll
        for (int ai = 0; ai < 2; ++ai)
#pragma unroll
            for (int m = 0; m < 4; ++m) {
                const int row = row0 + ai * HALF + m * 16; const float rs = rstd_of(rsv[ai][m]), k1 = rs * -1.4426950408889634f, rs2 = rs * rs;
                u32x4 w;
#pragma unroll
                for (int n = 0; n < 2; ++n)
#pragma unroll
                    for (int hp = 0; hp < 2; ++hp) {
                        const f32x2v g = (f32x2v){acc[ai][0][m][n][2 * hp], acc[ai][0][m][n][2 * hp + 1]}, uu = (f32x2v){acc[ai][1][m][n][2 * hp], acc[ai][1][m][n][2 * hp + 1]};
                        const f32x2v p = (g * uu) * rs2, a = g * k1;
                        f32x2v t; t.x = __builtin_amdgcn_exp2f(a.x); t.y = __builtin_amdgcn_exp2f(a.y);
                        const f32x2v d = t + 1.0f;
                        f32x2v r; r.x = __builtin_amdgcn_rcpf(d.x); r.y = __builtin_amdgcn_rcpf(d.y);
                        const f32x2v hv = p * r;
                        w[2 * n + hp] = cvt_pk_bf16(hv.x, hv.y);
                    }
                *(u32x4*)(H + (size_t)row * ldh + col0) = w;
            }
    }
};
typedef unsigned u32x2 __attribute__((ext_vector_type(2)));
struct EpiRes {
    static constexpr bool PERM = true, AFTER_DRAIN = false;
    bf16_t* xh; float* ssq_out; float alpha;
    __device__ __forceinline__ void load4(u32x4 (&hv)[4][2], size_t off0) const {
#pragma unroll
        for (int m = 0; m < 4; ++m)
#pragma unroll
            for (int bj = 0; bj < 2; ++bj) hv[m][bj] = *(const u32x4*)(xh + off0 + (size_t)m * 16 * 1024 + bj * HALF);
    }
    __device__ __forceinline__ float group(const f32x4 (&a)[2][4][2], int m, const u32x4 (&hv)[2], size_t off) const {
        float ss = 0.f;
#pragma unroll
        for (int bj = 0; bj < 2; ++bj) {
            float o[8];
#pragma unroll
            for (int e = 0; e < 8; ++e) {
                const unsigned hw = hv[bj][e >> 1];
                const float base = __builtin_bit_cast(float, (e & 1) ? (hw & 0xffff0000u) : (hw << 16));
                o[e] = base + a[bj][m][e >> 2][e & 3] * alpha; ss += o[e] * o[e];
            }
            u32x4 w; w.x = cvt_pk_bf16(o[0], o[1]); w.y = cvt_pk_bf16(o[2], o[3]); w.z = cvt_pk_bf16(o[4], o[5]); w.w = cvt_pk_bf16(o[6], o[7]);
            *(u32x4*)(xh + off + bj * HALF) = w;
        }
        ss += __shfl_xor(ss, 16); ss += __shfl_xor(ss, 32);
        return ss;
    }
    __device__ __forceinline__ void operator()(const f32x4 (&acc)[2][2][4][2], const Unit& u, int wr, int wc, int fr, int fq) const {
        const int row0 = u.pm * BM + wr * 64 + fr, col0 = u.pn * BM + wc * 32 + 8 * fq;
        const size_t off0 = (size_t)row0 * 1024 + col0, off1 = off0 + (size_t)HALF * 1024;
        u32x4 hA[4][2], hB[4][2];
        load4(hA, off0); load4(hB, off1);
        __builtin_amdgcn_sched_barrier(0);
        const int rbase = u.pm * BM + wr * 64 + 16 * fq + fr;
        float sa[4], sb[4];
#pragma unroll
        for (int m = 0; m < 4; ++m) sa[m] = group(acc[0], m, hA[m], off0 + (size_t)m * 16 * 1024);
        atomicAdd(ssq_out + rbase, fq == 0 ? sa[0] : fq == 1 ? sa[1] : fq == 2 ? sa[2] : sa[3]);
#pragma unroll
        for (int m = 0; m < 4; ++m) sb[m] = group(acc[1], m, hB[m], off1 + (size_t)m * 16 * 1024);
        atomicAdd(ssq_out + rbase + HALF, fq == 0 ? sb[0] : fq == 1 ? sb[1] : fq == 2 ? sb[2] : sb[3]);
    }
};
struct EpiResFinal {
    static constexpr bool PERM = true, AFTER_DRAIN = false;
    const bf16_t* xh; float* ssq_out; unsigned* cnt; const float* gain; float* out; float alpha;
    __device__ __forceinline__ void operator()(const f32x4 (&acc_c)[2][2][4][2], const Unit& u, int wr, int wc, int fr, int fq) const {
        f32x4 (&acc)[2][2][4][2] = const_cast<f32x4 (&)[2][2][4][2]>(acc_c);
        const int row0 = u.pm * BM + wr * 64 + fr, col0 = u.pn * BM + wc * 32 + 8 * fq;
        const size_t off0 = (size_t)row0 * 1024 + col0;
        u32x4 hv[2][4][2];
#pragma unroll
        for (int ai = 0; ai < 2; ++ai)
#pragma unroll
            for (int m = 0; m < 4; ++m)
#pragma unroll
                for (int bj = 0; bj < 2; ++bj) hv[ai][m][bj] = *(const u32x4*)(xh + off0 + (size_t)(ai * HALF + m * 16) * 1024 + bj * HALF);
        __builtin_amdgcn_sched_barrier(0);
#pragma unroll
        for (int ai = 0; ai < 2; ++ai) {
            float sv[4];
#pragma unroll
            for (int m = 0; m < 4; ++m) {
                float ss = 0.f;
#pragma unroll
                for (int bj = 0; bj < 2; ++bj)
#pragma unroll
                    for (int e = 0; e < 8; ++e) {
                        const unsigned hw = hv[ai][m][bj][e >> 1];
                        const float base = __builtin_bit_cast(float, (e & 1) ? (hw & 0xffff0000u) : (hw << 16));
                        const float o = base + acc[ai][bj][m][e >> 2][e & 3] * alpha; acc[ai][bj][m][e >> 2][e & 3] = o; ss += o * o;
                    }
                ss += __shfl_xor(ss, 16); ss += __shfl_xor(ss, 32);
                sv[m] = ss;
            }
            atomicAdd(ssq_out + u.pm * BM + wr * 64 + ai * HALF + 16 * fq + fr, fq == 0 ? sv[0] : fq == 1 ? sv[1] : fq == 2 ? sv[2] : sv[3]);
        }
        asm volatile("s_waitcnt vmcnt(0)" ::: "memory");
        unsigned* pc = cnt + 64 * u.pm;
        if ((threadIdx.x & 63) == 0) __hip_atomic_fetch_add(pc, 1u, __ATOMIC_RELAXED, __HIP_MEMORY_SCOPE_AGENT);
        { unsigned spins = 0;
          while ((unsigned)__builtin_amdgcn_readfirstlane(__hip_atomic_load(pc, __ATOMIC_RELAXED, __HIP_MEMORY_SCOPE_AGENT)) < 32u) { __builtin_amdgcn_s_sleep(2); if (++spins > (1u << 16)) break; } }
        float rs[2][4];
#pragma unroll
        for (int ai = 0; ai < 2; ++ai)
#pragma unroll
            for (int m = 0; m < 4; ++m) rs[ai][m] = rstd_of(__hip_atomic_load(ssq_out + row0 + ai * HALF + m * 16, __ATOMIC_RELAXED, __HIP_MEMORY_SCOPE_AGENT));
        f32x4 gv[2][2];
#pragma unroll
        for (int bj = 0; bj < 2; ++bj) { gv[bj][0] = *(const f32x4*)(gain + col0 + bj * HALF); gv[bj][1] = *(const f32x4*)(gain + col0 + bj * HALF + 4); }
#pragma unroll
        for (int ai = 0; ai < 2; ++ai)
#pragma unroll
            for (int m = 0; m < 4; ++m)
#pragma unroll
                for (int bj = 0; bj < 2; ++bj) {
                    float* op = out + off0 + (size_t)(ai * HALF + m * 16) * 1024 + bj * HALF;
                    *(f32x4*)op = acc[ai][bj][m][0] * rs[ai][m] * gv[bj][0]; *(f32x4*)(op + 4) = acc[ai][bj][m][1] * rs[ai][m] * gv[bj][1];
                }
    }
};
struct EpiZ {
    static constexpr bool PERM = true, AFTER_DRAIN = false;
    bf16_t *Q, *P; const float* ssq; size_t qk_stride, b_stride;
    __device__ __forceinline__ void operator()(const f32x4 (&acc)[2][2][4][2], const Unit& u, int wr, int wc, int fr, int fq) const {
        const int row0 = u.pm * BM + wr * 64 + fr, kind = u.pn >> 1;
        float rsv[2][4];
#pragma unroll
        for (int ai = 0; ai < 2; ++ai)
#pragma unroll
            for (int m = 0; m < 4; ++m) rsv[ai][m] = ssq[row0 + ai * HALF + m * 16];
        __builtin_amdgcn_sched_barrier(0);
        if (kind == 2) {
            const int colt = (u.pn & 1) * BM + wc * 32 + 8 * fq;
#pragma unroll
            for (int ai = 0; ai < 2; ++ai)
#pragma unroll
                for (int m = 0; m < 4; ++m) {
                    const int row = row0 + ai * HALF + m * 16; const float rs = rstd_of(rsv[ai][m]);
#pragma unroll
                    for (int bj = 0; bj < 2; ++bj) {
                        const f32x4 v0 = acc[ai][bj][m][0] * rs, v1 = acc[ai][bj][m][1] * rs;
                        u32x4 w; w.x = cvt_pk_bf16(v0[0], v0[1]); w.y = cvt_pk_bf16(v0[2], v0[3]); w.z = cvt_pk_bf16(v1[0], v1[1]); w.w = cvt_pk_bf16(v1[2], v1[3]);
                        *(u32x4*)(P + (size_t)row * 512 + colt + bj * HALF) = w;
                    }
                }
        } else {
            bf16_t* dst = Q + (size_t)kind * qk_stride; const float sc = kind == 0 ? 0.125f * 1.4426950408889634f : 1.0f;
            const int b = u.pm >> 3, h0 = 4 * (u.pn & 1) + (wc >> 1), ks = wc & 1;
#pragma unroll
            for (int ai = 0; ai < 2; ++ai)
#pragma unroll
                for (int m = 0; m < 4; ++m) {
                    const float rs = rstd_of(rsv[ai][m]) * sc;
                    const int grow = (u.pm & 7) * 4 + 2 * ai + wr, col = 16 * m + fr;
#pragma unroll
                    for (int bj = 0; bj < 2; ++bj) {
                        const f32x4 v0 = acc[ai][bj][m][0] * rs, v1 = acc[ai][bj][m][1] * rs;
                        u32x4 w; w.x = cvt_pk_bf16(v0[0], v0[1]); w.y = cvt_pk_bf16(v0[2], v0[3]); w.z = cvt_pk_bf16(v1[0], v1[1]); w.w = cvt_pk_bf16(v1[2], v1[3]);
                        const size_t idx = (size_t)b * b_stride + ((((size_t)((h0 + 2 * bj) * 32 + grow) * 2 + ks) * 4 + fq) * 64 + col) * 8;
                        *(u32x4*)(dst + idx) = w;
                    }
                }
        }
    }
};
struct EpiVT {
    static constexpr bool PERM = true, AFTER_DRAIN = false;
    bf16_t* VF; const float* ssq;
    __device__ __forceinline__ void operator()(const f32x4 (&acc)[2][2][4][2], const Unit& u, int wr, int wc, int fr, int fq) const {
        typedef unsigned u32x2 __attribute__((ext_vector_type(2)));
        const int b = u.pn >> 3, tok0 = u.pn * BM + wc * 32 + 8 * fq;
        f32x4 sqv[2][2];
#pragma unroll
        for (int bj = 0; bj < 2; ++bj)
#pragma unroll
            for (int n = 0; n < 2; ++n) sqv[bj][n] = *(const f32x4*)(ssq + tok0 + bj * HALF + 4 * n);
        __builtin_amdgcn_sched_barrier(0);
#pragma unroll
        for (int bj = 0; bj < 2; ++bj)
#pragma unroll
            for (int n = 0; n < 2; ++n) {
                const f32x4 sq = sqv[bj][n];
                const f32x4 rs = (f32x4){rstd_of(sq[0]), rstd_of(sq[1]), rstd_of(sq[2]), rstd_of(sq[3])};
                const int grow = (u.pn & 7) * 4 + 2 * bj + (wc >> 1), cg = (wc & 1) * 8 + 2 * fq + n;
#pragma unroll
                for (int ai = 0; ai < 2; ++ai)
#pragma unroll
                    for (int m = 0; m < 4; ++m) {
                        const int h = 4 * u.pm + 2 * ai + wr;
                        const f32x4 v = acc[ai][bj][m][n] * rs;
                        u32x2 w; w.x = cvt_pk_bf16(v[0], v[1]); w.y = cvt_pk_bf16(v[2], v[3]);
                        *(u32x2*)(VF + ((((size_t)((b * 8 + h) * 32 + grow) * 16 + cg) * 64 + ((m ^ n) * 16 + fr)) * 4)) = w;
                    }
            }
    }
};

struct EpiNull {
    static constexpr bool PERM = true, AFTER_DRAIN = false;
    float* out;
    __device__ __forceinline__ void operator()(const f32x4 (&acc)[2][2][4][2], const Unit& u, int wr, int wc, int fr, int fq) const {
        float s = 0.f;
#pragma unroll
        for (int ai = 0; ai < 2; ++ai)
#pragma unroll
            for (int bj = 0; bj < 2; ++bj)
#pragma unroll
                for (int m = 0; m < 4; ++m)
#pragma unroll
                    for (int n = 0; n < 2; ++n) s += acc[ai][bj][m][n][0] + acc[ai][bj][m][n][1] + acc[ai][bj][m][n][2] + acc[ai][bj][m][n][3];
        if (s == 1.2345e38f) out[u.pm] = s;
    }
};

struct WinOrder {
    StaticOrder z, v; int nzc;
    __device__ void init(int M, int G, int c) { z.init(M, 1536, G, c); v.init(512, M, G, c); nzc = (z.nwg - c + G - 1) / G; if (nzc < 0) nzc = 0; }
    __device__ bool next(int i, Unit& u) const {
        if (i < nzc) return z.next(i, u);
        if (!v.next(i - nzc, u)) return false;
        u.pm += 6; u.swp = 1; return true;
    }
    __device__ __forceinline__ void a_ready(const Unit&) const {}
    __device__ __forceinline__ void done(const Unit&) const {}
};
struct EpiZV {
    static constexpr bool PERM = true, AFTER_DRAIN = false;
    EpiZ ez; EpiVT ev;
    __device__ __forceinline__ void operator()(const f32x4 (&acc)[2][2][4][2], const Unit& u, int wr, int wc, int fr, int fq) const {
        if (u.swp) { Unit uv; uv.pm = u.pm - 6; uv.pn = u.pn; uv.swp = 1; ev(acc, uv, wr, wc, fr, fq); } else ez(acc, u, wr, wc, fr, fq);
    }
};
template <class Epi, class Sched, bool ALIGN_EPI = false, bool SP2 = false>
__device__ __forceinline__ void gemm_phase(PG8_LAS unsigned char* lds, const Gemm g, const Sched& S, const Epi& E) {
    int tid_ = threadIdx.x; asm volatile("" : "+v"(tid_));
    const int tid = tid_, wid = __builtin_amdgcn_readfirstlane(tid >> 6), lane = tid & 63, wr = wid >> 2, wc = wid & 3, fr = lane & 15, fq = lane >> 4;
    const int K = g.K, nt = K / BK;
    unsigned voffA[2], voffB[2];
#pragma unroll
    for (int i = 0; i < 2; ++i) { int R, C; stage_rc(tid * 16 + i * 8192, R, C); const int Rb = Epi::PERM ? ((R & ~31) + perm32(R & 31)) : R;
        voffA[i] = (unsigned)(R * K + C) * 2u; voffB[i] = (unsigned)(Rb * K + C) * 2u; }
    const size_t kstep = (size_t)(BK * 2);
    const size_t hstep = (size_t)HALF * K * 2;
    const size_t tstep = 2 * hstep;
    const unsigned ldsw = (unsigned)wid * 1024u;
    const int aoff = lds_byte(wr * 64 + fr, fq * 8), boff = lds_byte(wc * 32 + fr, fq * 8);
#define PG8_SA(b, h) (((b) * 2 + (h)) * HTB)
#define PG8_SB(b, h) ((4 + (b) * 2 + (h)) * HTB)
#define PG8_STAGE(bufoff, gbase, voff) do { _Pragma("unroll") for (int _i = 0; _i < 2; ++_i) \
        __builtin_amdgcn_global_load_lds((const unsigned*)((const char*)(gbase) + (voff)[_i]), (PG8_LAS unsigned*)(lds + (bufoff) + ldsw + _i * 8192), 16, 0, 0); } while (0)
#define PG8_LDA(dst, b, h) do { _Pragma("unroll") for (int m = 0; m < 4; ++m) _Pragma("unroll") for (int k = 0; k < 2; ++k) dst[m][k] = *(const PG8_LAS bf16x8*)(lds + PG8_SA(b, h) + aoff + m * 2048 + k * 1024); } while (0)
#define PG8_LDB(dst, b, h) do { _Pragma("unroll") for (int n = 0; n < 2; ++n) _Pragma("unroll") for (int k = 0; k < 2; ++k) dst[n][k] = *(const PG8_LAS bf16x8*)(lds + PG8_SB(b, h) + boff + n * 2048 + k * 1024); } while (0)
#define PG8_MMA(ai, bj, At, Bt) do { __builtin_amdgcn_s_setprio(1); _Pragma("unroll") for (int m = 0; m < 4; ++m) _Pragma("unroll") for (int n = 0; n < 2; ++n) _Pragma("unroll") for (int k = 0; k < 2; ++k) \
        acc[ai][bj][m][n] = __builtin_amdgcn_mfma_f32_16x16x32_bf16(Bt[n][k], At[m][k], acc[ai][bj][m][n], 0, 0, 0); __builtin_amdgcn_s_setprio(0); } while (0)
#define PG8_WAIT_V(n) asm volatile("s_waitcnt vmcnt(" #n ")" ::: "memory")
#define PG8_WAIT_L(n) asm volatile("s_waitcnt lgkmcnt(" #n ")" ::: "memory")
#define PG8_BAR __builtin_amdgcn_s_barrier()
#define PG8_SCHED __builtin_amdgcn_sched_barrier(0)
    Unit cur, nxt; int ui = 0;
    if (!S.next(0, cur)) return;
    f32x4 acc[2][2][4][2];
#pragma unroll
    for (int a = 0; a < 2; ++a)
#pragma unroll
        for (int b = 0; b < 2; ++b)
#pragma unroll
            for (int m = 0; m < 4; ++m)
#pragma unroll
                for (int n = 0; n < 2; ++n) acc[a][b][m][n] = (f32x4){0.f, 0.f, 0.f, 0.f};
    bf16x8 At[4][2], B0[2][2], B1[2][2];
    const char* cA = (const char*)(cur.swp ? g.Bt : g.A) + (size_t)cur.pm * tstep; const char* cB = (const char*)(cur.swp ? g.A : g.Bt) + (size_t)cur.pn * tstep;
    S.a_ready(cur);
    if constexpr (SP2) {
        PG8_STAGE(PG8_SB(0, 0), cB, voffB); PG8_STAGE(PG8_SB(0, 1), cB + hstep, voffB); PG8_STAGE(PG8_SA(0, 0), cA, voffA); PG8_STAGE(PG8_SA(0, 1), cA + hstep, voffA);
        if (wr == 1) PG8_BAR;
        PG8_WAIT_V(2); PG8_BAR;
        PG8_STAGE(PG8_SB(1, 0), cB + kstep, voffB); PG8_STAGE(PG8_SA(1, 0), cA + kstep, voffA); PG8_STAGE(PG8_SB(1, 1), cB + hstep + kstep, voffB);
        PG8_WAIT_V(6); PG8_BAR;
    } else {
        PG8_STAGE(PG8_SB(0, 0), cB, voffB); PG8_STAGE(PG8_SA(0, 0), cA, voffA); PG8_STAGE(PG8_SB(0, 1), cB + hstep, voffB); PG8_STAGE(PG8_SA(0, 1), cA + hstep, voffA);
        if (wr == 1) PG8_BAR;
        PG8_WAIT_V(4); PG8_BAR;
        PG8_STAGE(PG8_SB(1, 0), cB + kstep, voffB); PG8_STAGE(PG8_SA(1, 0), cA + kstep, voffA); PG8_STAGE(PG8_SB(1, 1), cB + hstep + kstep, voffB);
        PG8_WAIT_V(6); PG8_BAR;
    }
    for (;;) {
        const bool has_next = S.next(ui + 1, nxt);
        const char* nA = has_next ? (const char*)(nxt.swp ? g.Bt : g.A) + (size_t)nxt.pm * tstep : cA; const char* nB = has_next ? (const char*)(nxt.swp ? g.A : g.Bt) + (size_t)nxt.pn * tstep : cB;
        for (int t = 0; t < nt; t += 2) {
            const bool last = (t == nt - 2);
            const char* a1 = cA + (size_t)(t + 1) * kstep;
            const char* a2 = last ? nA : cA + (size_t)(t + 2) * kstep; const char* b2 = last ? nB : cB + (size_t)(t + 2) * kstep;
            const char* a3 = a2 + kstep; const char* b3 = b2 + kstep;
            if (last && has_next) S.a_ready(nxt);
            if constexpr (SP2) {
            PG8_LDB(B0, 0, 0); PG8_LDB(B1, 0, 1); PG8_SCHED; PG8_LDA(At, 0, 0); PG8_STAGE(PG8_SA(1, 1), a1 + hstep, voffA);
            PG8_WAIT_V(8); PG8_WAIT_L(0); PG8_BAR; PG8_MMA(0, 0, At, B0); PG8_MMA(0, 1, At, B1); PG8_BAR; PG8_SCHED;
            PG8_LDA(At, 0, 1); PG8_STAGE(PG8_SB(0, 0), b2, voffB); PG8_STAGE(PG8_SB(0, 1), b2 + hstep, voffB); PG8_STAGE(PG8_SA(0, 0), a2, voffA);
            PG8_WAIT_V(8); PG8_WAIT_L(0); PG8_BAR; PG8_MMA(1, 0, At, B0); PG8_MMA(1, 1, At, B1); PG8_BAR; PG8_SCHED;
            PG8_LDB(B0, 1, 0); PG8_LDB(B1, 1, 1); PG8_SCHED; PG8_LDA(At, 1, 0); PG8_STAGE(PG8_SA(0, 1), a2 + hstep, voffA);
            PG8_WAIT_V(8); PG8_WAIT_L(0); PG8_BAR; PG8_MMA(0, 0, At, B0); PG8_MMA(0, 1, At, B1); PG8_BAR; PG8_SCHED;
            PG8_LDA(At, 1, 1); PG8_STAGE(PG8_SB(1, 0), b3, voffB); PG8_STAGE(PG8_SB(1, 1), b3 + hstep, voffB); PG8_STAGE(PG8_SA(1, 0), a3, voffA);
            PG8_WAIT_V(8); PG8_WAIT_L(0); PG8_BAR; PG8_MMA(1, 0, At, B0); PG8_MMA(1, 1, At, B1); PG8_BAR; PG8_SCHED;
            } else {
            PG8_LDB(B0, 0, 0); PG8_SCHED; PG8_LDA(At, 0, 0); PG8_STAGE(PG8_SA(1, 1), a1 + hstep, voffA);
            PG8_WAIT_L(8); PG8_BAR; PG8_WAIT_L(0); PG8_MMA(0, 0, At, B0); PG8_BAR; PG8_SCHED;
            PG8_LDB(B1, 0, 1); PG8_STAGE(PG8_SB(0, 0), b2, voffB);
            PG8_BAR; PG8_WAIT_L(0); PG8_MMA(0, 1, At, B1); PG8_BAR;
            PG8_LDA(At, 0, 1); PG8_STAGE(PG8_SA(0, 0), a2, voffA);
            PG8_BAR; PG8_WAIT_L(0); PG8_MMA(1, 0, At, B0); PG8_BAR; PG8_SCHED;
            PG8_STAGE(PG8_SB(0, 1), b2 + hstep, voffB);
            PG8_WAIT_V(6); PG8_BAR; PG8_MMA(1, 1, At, B1); PG8_BAR;
            PG8_LDB(B0, 1, 0); PG8_SCHED; PG8_LDA(At, 1, 0); PG8_STAGE(PG8_SA(0, 1), a2 + hstep, voffA);
            PG8_WAIT_L(8); PG8_BAR; PG8_WAIT_L(0); PG8_MMA(0, 0, At, B0); PG8_BAR; PG8_SCHED;
            PG8_LDB(B1, 1, 1); PG8_STAGE(PG8_SB(1, 0), b3, voffB);
            PG8_BAR; PG8_WAIT_L(0); PG8_MMA(0, 1, At, B1); PG8_BAR;
            PG8_LDA(At, 1, 1); PG8_STAGE(PG8_SA(1, 0), a3, voffA);
            PG8_BAR; PG8_WAIT_L(0); PG8_MMA(1, 0, At, B0); PG8_BAR; PG8_SCHED;
            PG8_STAGE(PG8_SB(1, 1), b3 + hstep, voffB);
            PG8_WAIT_V(6); PG8_BAR; PG8_MMA(1, 1, At, B1); PG8_BAR;
            }
        }
        if constexpr (ALIGN_EPI) { if (wr == 0) PG8_BAR; }
        if constexpr (!Epi::AFTER_DRAIN) { E(acc, cur, wr, wc, fr, fq); S.done(cur); }
        if (!has_next) break;
#pragma unroll
        for (int a = 0; a < 2; ++a)
#pragma unroll
            for (int b = 0; b < 2; ++b)
#pragma unroll
                for (int m = 0; m < 4; ++m)
#pragma unroll
                    for (int n = 0; n < 2; ++n) acc[a][b][m][n] = (f32x4){0.f, 0.f, 0.f, 0.f};
        cur = nxt; cA = nA; cB = nB; ++ui;
        if constexpr (ALIGN_EPI) { if (wr == 1) PG8_BAR; }
    }
    PG8_WAIT_V(0);
    if constexpr (!ALIGN_EPI) { if (wr == 0) PG8_BAR; }
    PG8_BAR;
    if constexpr (Epi::AFTER_DRAIN) { E.fused(acc, cur, wr, wc, fr, fq, lds, wid, lane); S.done(cur); }
#undef PG8_SA
#undef PG8_SB
#undef PG8_STAGE
#undef PG8_LDA
#undef PG8_LDB
#undef PG8_MMA
#undef PG8_WAIT_V
#undef PG8_WAIT_L
#undef PG8_BAR
#undef PG8_SCHED
}
}
constexpr int NB = 16, SEQ = 2048, D = 1024, M = NB * SEQ, FF = 2816, NIN = 2048, DEPTH = 2;
constexpr int NWAVES = 8;
constexpr size_t MiB = 1u << 20;
constexpr size_t WS_PCNT = 1 * MiB + 64 * 1024;
constexpr size_t WS_BAR = 1 * MiB;
constexpr size_t WS_SSQ = 0;
constexpr size_t WS_W = 2 * MiB, W_LAYER = 39 * MiB;
constexpr size_t WO_GU1 = 0, WO_D1 = 11 * MiB, WO_IN = 16 * MiB + MiB / 2, WO_OUT = 20 * MiB + MiB / 2, WO_GU2 = 22 * MiB + MiB / 2, WO_D2 = 33 * MiB + MiB / 2;
constexpr size_t WS_XB = 80 * MiB;
constexpr size_t WS_H = 144 * MiB;
constexpr size_t WS_P = 320 * MiB, WS_VT = 352 * MiB, WS_CAT = 384 * MiB, WS_END = 448 * MiB;
constexpr size_t WS_GBAR = 1 * MiB + 16 * 1024;
constexpr size_t QK_BSTRIDE = 4194304, QK_KOFF = 1048576;
constexpr unsigned STAGGER_TICKS = 0;
static_assert(WS_H + (size_t)M * FF * 2 <= WS_P && WS_W + 2 * W_LAYER <= WS_XB, "d_ws map");
constexpr int LDS_BYTES = 150272;
constexpr int MISC_OFF = 150016;

#define GAS __attribute__((address_space(1)))
#define LAS __attribute__((address_space(3)))
typedef unsigned short bf16;
typedef unsigned v4u __attribute__((ext_vector_type(4)));
typedef unsigned v2u __attribute__((ext_vector_type(2)));
typedef float f32x4 __attribute__((ext_vector_type(4)));
typedef short bf16x8 __attribute__((ext_vector_type(8)));
#define LDS_WAIT() asm volatile("s_waitcnt lgkmcnt(0)" ::: "memory")
__device__ __forceinline__ unsigned f2bf(float f) { unsigned u = __builtin_bit_cast(unsigned, f); return (u + 0x7fffu + ((u >> 16) & 1u)) >> 16; }
typedef float f32x2_pk __attribute__((ext_vector_type(2))); typedef __bf16 bf16x2_pk __attribute__((ext_vector_type(2)));
__device__ __forceinline__ unsigned pk2(float lo, float hi) { const f32x2_pk v = {lo, hi}; return __builtin_bit_cast(unsigned, __builtin_convertvector(v, bf16x2_pk)); }
__device__ __forceinline__ float bflo(unsigned w) { return __builtin_bit_cast(float, w << 16); }
__device__ __forceinline__ float bfhi(unsigned w) { return __builtin_bit_cast(float, w & 0xffff0000u); }
__device__ __forceinline__ float wave_sum(float v) {
#pragma unroll
    for (int o = 1; o < 64; o <<= 1) v += __shfl_xor(v, o);
    return v;
}

#define XB_TMO      128
#define XB_XCNT(j)  (256  + 64 * (j))
#define XB_XSUB(j)  (1280 + 64 * (j))
#define XB_XGEN(j)  (2304 + 64 * (j))
#define XB_TOP      3328
#define XB_TOPGEN   3392
#define XCD_BAR_WORDS 3456
#define XB_GX(k)    (5120 + 64 * (k))
#define XB_ALL_WORDS 13312
#define XB_SPIN_CAP (1u << 18)

__device__ __forceinline__ unsigned xb_ld(unsigned* p)              { return __hip_atomic_load(p, __ATOMIC_RELAXED, __HIP_MEMORY_SCOPE_AGENT); }
__device__ __forceinline__ unsigned xb_add(unsigned* p, unsigned v) { return __hip_atomic_fetch_add(p, v, __ATOMIC_RELAXED, __HIP_MEMORY_SCOPE_AGENT); }
__device__ __forceinline__ unsigned xb_xcc_id() { return (unsigned)__builtin_amdgcn_s_getreg((3 << 11) | 20) & 0xFu; }
#define XB_SPIN(cond, bar) do { unsigned _sp = 0; while (cond) { __builtin_amdgcn_s_sleep(1); \
    if ((++_sp & 255u) == 0u) { if (xb_ld(&(bar)[XB_TMO])) break; if (_sp > XB_SPIN_CAP) { atomicAdd(&(bar)[XB_TMO], 1u); break; } } } } while (0)

struct XcdBarrier {
    unsigned* bar; unsigned x;
    volatile LAS unsigned* st;
};

__device__ __forceinline__ XcdBarrier xcd_barrier_post(unsigned* bar, volatile LAS unsigned* st) {
    XcdBarrier b; b.bar = bar; b.x = xb_xcc_id(); b.st = st;
    if (threadIdx.x == 0) { (void)xb_add(&bar[XB_XCNT(b.x)], 1u); (void)xb_add(&bar[XB_GX(b.x * 8u + (blockIdx.x & 7u))], 1u); }
    return b;
}
__device__ __forceinline__ void xcd_barrier_complete(unsigned* bar, unsigned x, unsigned& nloc, unsigned& nx) {
    const unsigned G = gridDim.x * gridDim.y * gridDim.z;
    unsigned sum, cnt, mine, sp = 0u;
    for (;;) {
        sum = 0u; cnt = 0u; mine = 0u;
#pragma unroll
        for (unsigned j = 0; j < 16; ++j) { const unsigned c = xb_ld(&bar[XB_XCNT(j)]); sum += c; cnt += (c > 0u) ? 1u : 0u; mine = (j == x) ? c : mine; }
        if (sum == G) break;
        __builtin_amdgcn_s_sleep(1);
        if ((++sp & 255u) == 0u) { if (xb_ld(&bar[XB_TMO])) break; if (sp > XB_SPIN_CAP) { atomicAdd(&bar[XB_TMO], 1u); break; } }
    }
    nloc = mine > 0u ? mine : 1u; nx = cnt > 0u ? cnt : 1u;
}

__device__ __forceinline__ void xcd_barrier(const XcdBarrier& b, bool local = false) {
    asm volatile("s_waitcnt vmcnt(0)" ::: "memory");
    __syncthreads();
    if (threadIdx.x == 0) {
        unsigned* bar = b.bar;
        __builtin_amdgcn_s_waitcnt(0);
        unsigned nloc = b.st[0], nx = b.st[1];
        if (nloc == 0u) { xcd_barrier_complete(bar, b.x, nloc, nx); b.st[0] = nloc; b.st[1] = nx; }
        const unsigned old = xb_add(&bar[XB_XSUB(b.x)], 1u);
        const unsigned gen = old / nloc;
        if (old + 1u == (gen + 1u) * nloc) {
            if (!local)
            __builtin_amdgcn_fence(__ATOMIC_RELEASE, "agent");
            asm volatile("s_waitcnt vmcnt(0)" ::: "memory");
            if (!local) {
            const unsigned og = xb_add(&bar[XB_TOP], 1u);
            const unsigned tg = og / nx;
            if (og + 1u == (tg + 1u) * nx) xb_add(&bar[XB_TOPGEN], 1u);
            else XB_SPIN(xb_ld(&bar[XB_TOPGEN]) == tg, bar);
            }
            __builtin_amdgcn_fence(__ATOMIC_ACQUIRE, "agent");
            xb_add(&bar[XB_XGEN(b.x)], 1u);
            asm volatile("s_waitcnt vmcnt(0)" ::: "memory");
        } else {
            XB_SPIN(xb_ld(&bar[XB_XGEN(b.x)]) == gen, bar);
            __builtin_amdgcn_fence(__ATOMIC_ACQUIRE, "agent");
            asm volatile("s_waitcnt vmcnt(0)" ::: "memory");
        }
    }
    __syncthreads();
}


__device__ __forceinline__ void grp_barrier(unsigned* cnt, volatile LAS unsigned* seqw) {
    asm volatile("s_waitcnt vmcnt(0)" ::: "memory");
    __syncthreads();
    if (threadIdx.x == 0) {
        __builtin_amdgcn_fence(__ATOMIC_RELEASE, "agent"); asm volatile("s_waitcnt vmcnt(0)" ::: "memory");
        const unsigned want = 32u * (seqw[0] + 1u); seqw[0] = seqw[0] + 1u;
        (void)xb_add(cnt, 1u);
        unsigned sp = 0u;
        while (xb_ld(cnt) < want) { __builtin_amdgcn_s_sleep(1); if (++sp > (1u << 22)) break; }
        __builtin_amdgcn_fence(__ATOMIC_ACQUIRE, "agent"); asm volatile("s_waitcnt vmcnt(0)" ::: "memory");
    }
    __syncthreads();
}

typedef float f32x2 __attribute__((ext_vector_type(2)));
__device__ __forceinline__ void transpose_item(const float* W, int ldw, const float* gain, bf16* WT, int ldt, int k0, int n0, int drow0, int lane) {
    const float* src = W + (size_t)k0 * ldw + n0 + 2 * lane;
    bf16* d0 = WT + (size_t)(drow0 + 2 * lane) * ldt + k0;
    f32x2 v[64];
#pragma unroll
    for (int kk = 0; kk < 64; ++kk) v[kk] = *(const f32x2*)(src + (size_t)kk * ldw);
    const float gl = gain ? gain[k0 + lane] : 1.0f;
#pragma unroll
    for (int col = 0; col < 2; ++col) {
#pragma unroll
        for (int c = 0; c < 8; ++c) {
            float e[8];
#pragma unroll
            for (int kk = 0; kk < 8; ++kk) { const float gk = __builtin_bit_cast(float, __builtin_amdgcn_readlane(__builtin_bit_cast(int, gl), 8 * c + kk)); e[kk] = (col ? v[8 * c + kk].y : v[8 * c + kk].x) * gk; }
            v4u o; o.x = pk2(e[0], e[1]); o.y = pk2(e[2], e[3]); o.z = pk2(e[4], e[5]); o.w = pk2(e[6], e[7]);
            *(v4u*)(d0 + (size_t)col * ldt + 8 * c) = o;
        }
    }
}
struct LayerW { const float *n1, *g1, *u1, *d1, *nm, *win, *rpb, *wpool, *pscale, *wout, *n2, *g2, *u2, *d2; bf16 *GU1, *D1, *WIN, *WOUT, *GU2, *D2; };
__device__ __forceinline__ LayerW layer_w(const float* const* in, unsigned char* ws, int l) {
    LayerW w;
    w.n1 = in[1] + (size_t)l * D; w.g1 = in[2] + (size_t)l * D * FF; w.u1 = in[3] + (size_t)l * D * FF; w.d1 = in[4] + (size_t)l * FF * D;
    w.nm = in[5] + (size_t)l * D; w.win = in[6] + (size_t)l * D * NIN; w.rpb = in[7] + (size_t)l * 8 * 15 * 31; w.wpool = in[8] + (size_t)l * 4 * 128 * 128;
    w.pscale = in[9] + (size_t)l * 512; w.wout = in[10] + (size_t)l * D * D; w.n2 = in[11] + (size_t)l * D;
    w.g2 = in[12] + (size_t)l * D * FF; w.u2 = in[13] + (size_t)l * D * FF; w.d2 = in[14] + (size_t)l * FF * D;
    unsigned char* b = ws + WS_W + (size_t)l * W_LAYER;
    w.GU1 = (bf16*)(b + WO_GU1); w.D1 = (bf16*)(b + WO_D1); w.WIN = (bf16*)(b + WO_IN); w.WOUT = (bf16*)(b + WO_OUT); w.GU2 = (bf16*)(b + WO_GU2); w.D2 = (bf16*)(b + WO_D2);
    return w;
}
__device__ __forceinline__ void prologue(const float* const* in, unsigned char* ws, int gw, int NGW, int lane, int part) {
    constexpr int I_GU = (D / 64) * (FF / 128), I_DN = (FF / 64) * (D / 128), I_IN = (D / 64) * (NIN / 128), I_OUT = (512 / 64) * (D / 128), I_FOLD = 4 * 16 * 16;
    constexpr int I_LAYER = 4 * I_GU + 2 * I_DN + I_IN + I_OUT + I_FOLD;
    if (part & 1)
    for (int it = gw; it < DEPTH * I_LAYER; it += NGW) {
        const int l = it / I_LAYER; int r = it % I_LAYER; const LayerW w = layer_w(in, ws, l);
        if (r < 4 * I_GU) {
            const int which = r / I_GU; r %= I_GU; const int nkb = D / 64, kb = r % nkb, nb = r / nkb;
            const float* W = which == 0 ? w.g1 : which == 1 ? w.u1 : which == 2 ? w.g2 : w.u2; const float* gn = which < 2 ? w.n1 : w.n2; bf16* T = which < 2 ? w.GU1 : w.GU2;
            transpose_item(W, FF, gn, T, D, 64 * kb, 128 * nb, nb * 256 + (which & 1) * 128, lane); continue; }
        r -= 4 * I_GU;
        if (r < 2 * I_DN) { const int which = r / I_DN; r %= I_DN; const int nkb = FF / 64, kb = r % nkb, nb = r / nkb;
            transpose_item(which ? w.d2 : w.d1, D, nullptr, which ? w.D2 : w.D1, FF, 64 * kb, 128 * nb, 128 * nb, lane); continue; }
        r -= 2 * I_DN;
        if (r < I_IN) { const int nkb = D / 64, kb = r % nkb, nb = r / nkb; const int n0 = 128 * nb; transpose_item(w.win, NIN, w.nm, w.WIN, D, 64 * kb, n0, n0 < 1024 ? n0 : (n0 < 1536 ? n0 + 512 : n0 - 512), lane); continue; }
        r -= I_IN;
        if (r < I_OUT) { const int nkb = 512 / 64, kb = r % nkb, nb = r / nkb; transpose_item(w.wout, D, nullptr, w.WOUT, D, 64 * kb, 128 * nb, 128 * nb, lane); continue; }
        r -= I_OUT;
        {
            const int g = r >> 8, nb = (r >> 4) & 15, cb = r & 15, n = 64 * nb + lane;
            const float* wp = w.wpool + ((size_t)g * 128 + 8 * cb) * 128; const float* sc = w.pscale + 128 * g; const float* wo = w.wout + (size_t)(512 + 128 * g) * D + n;
            float wr_[8][2], sr_[2];
#pragma unroll
            for (int hh = 0; hh < 2; ++hh) { sr_[hh] = sc[64 * hh + lane];
#pragma unroll
                for (int c = 0; c < 8; ++c) wr_[c][hh] = wp[c * 128 + 64 * hh + lane]; }
#pragma unroll
            for (int hh = 0; hh < 2; ++hh)
#pragma unroll
                for (int c = 0; c < 8; ++c) wr_[c][hh] *= sr_[hh];
            float a[8];
#pragma unroll
            for (int c = 0; c < 8; ++c) a[c] = 0.f;
#pragma unroll
            for (int hh = 0; hh < 2; ++hh)
#pragma unroll
                for (int q = 0; q < 2; ++q) {
                    float x[32];
#pragma unroll
                    for (int dd = 0; dd < 32; ++dd) x[dd] = wo[(size_t)(64 * hh + 32 * q + dd) * D];
#pragma unroll
                    for (int dd = 0; dd < 32; ++dd)
#pragma unroll
                        for (int c = 0; c < 8; ++c) a[c] += __builtin_bit_cast(float, __builtin_amdgcn_readlane(__builtin_bit_cast(int, wr_[c][hh]), 32 * q + dd)) * x[dd];
                }
            v4u o; o.x = pk2(a[0], a[1]); o.y = pk2(a[2], a[3]); o.z = pk2(a[4], a[5]); o.w = pk2(a[6], a[7]);
            *(v4u*)(w.WOUT + (size_t)n * D + 512 + 128 * g + 8 * cb) = o;
        }
    }
    if (!(part & 2)) return;
    const float* x = in[0]; bf16* XB = (bf16*)(ws + WS_XB); float* ssq = (float*)(ws + WS_SSQ);
    for (int m = gw; m < M; m += NGW) {
        const f32x4* xr = (const f32x4*)(x + (size_t)m * D) + lane; f32x4 v[4]; float s = 0.f;
#pragma unroll
        for (int j = 0; j < 4; ++j) { v[j] = xr[64 * j]; s += (v[j].x * v[j].x + v[j].y * v[j].y) + (v[j].z * v[j].z + v[j].w * v[j].w); }
        s = wave_sum(s);
        v2u* o8 = (v2u*)(XB + (size_t)m * D) + lane;
#pragma unroll
        for (int j = 0; j < 4; ++j) { v2u o; o.x = pk2(v[j].x, v[j].y); o.y = pk2(v[j].z, v[j].w); o8[64 * j] = o; }
        if (lane == 0) ssq[m] = s;
    }
    for (int i = gw * 64 + lane; i < 6 * M; i += NGW * 64) ssq[M + i] = 0.f;
    { unsigned* pc = (unsigned*)(ws + WS_PCNT); for (int i = gw * 64 + lane; i < 128 * 64; i += NGW * 64) pc[i] = 0u; }
}

__device__ __forceinline__ void acc8(float (&s)[8], const v4u v, const float sg) {
    s[0] += sg * bflo(v.x); s[1] += sg * bfhi(v.x); s[2] += sg * bflo(v.y); s[3] += sg * bfhi(v.y); s[4] += sg * bflo(v.z); s[5] += sg * bfhi(v.z); s[6] += sg * bflo(v.w); s[7] += sg * bfhi(v.w);
}
template <int W2> __device__ __forceinline__ void pool_block(const bf16* P, bf16* CAT, int tb, int g, int lane) {
    constexpr int W = 2 * W2, R = W + 15;
    const int q = lane >> 4, c8 = 8 * (lane & 15), row0 = 64 * tb + 16 * q, t0 = row0 & (SEQ - 1);
    const bf16* pb = P + (size_t)(row0 - t0) * 512 + g * 128 + c8;
    v4u r[R];
#pragma unroll
    for (int k = 0; k < R; ++k) { const int t = t0 - W2 + k, tc = min(max(t, 0), SEQ - 1);
        v4u v = *(const v4u*)(pb + (size_t)tc * 512);
        r[k] = v; }
    __builtin_amdgcn_sched_barrier(0);
#pragma unroll
    for (int k = 0; k < R; ++k) { const int t = t0 - W2 + k; if (t < 0 || t >= SEQ) r[k] = (v4u){0u, 0u, 0u, 0u}; }
    float s[8];
#pragma unroll
    for (int e = 0; e < 8; ++e) s[e] = 0.f;
#pragma unroll
    for (int k = 0; k < W; ++k) acc8(s, r[k], 1.0f);
    bf16* ob = CAT + (size_t)row0 * 1024 + 512 + g * 128 + c8;
#pragma unroll
    for (int i = 0; i < 16; ++i) {
        const int t = t0 + i, cnt = min(t + W2, SEQ) - max(t - W2, 0); const float ic = 1.0f / (float)cnt; const v4u cv = r[i + W2];
        v4u o; o.x = pg8::cvt_pk_bf16(s[0] * ic - bflo(cv.x), s[1] * ic - bfhi(cv.x)); o.y = pg8::cvt_pk_bf16(s[2] * ic - bflo(cv.y), s[3] * ic - bfhi(cv.y));
        o.z = pg8::cvt_pk_bf16(s[4] * ic - bflo(cv.z), s[5] * ic - bfhi(cv.z)); o.w = pg8::cvt_pk_bf16(s[6] * ic - bflo(cv.w), s[7] * ic - bfhi(cv.w));
        *(v4u*)(ob + (size_t)i * 1024) = o;
        if (i < 15) { acc8(s, r[i + W], 1.0f); acc8(s, r[i], -1.0f); }
    }
}
constexpr int AT_SLOT = 16384, AT_NSLOT = 9, AT_TBL_OFF = AT_NSLOT * AT_SLOT + 256;
__device__ __forceinline__ int at_rs(int r) { return min(max(r - 4, 0), 24); }
__device__ __forceinline__ void attn_pool_phase(LAS unsigned char* lds, const bf16* Q, const bf16* K, const bf16* VT, const bf16* P, bf16* CAT, const float* rpb,
                                                int vcu, int G, int wave, int lane, int tid, int probe_mask = 3) {
    LAS float* tbl = (LAS float*)(lds + AT_TBL_OFF);
    const int j = wave & 3, rsub = wave >> 2, ql = lane & 15, quad = lane >> 4;
    const int c = 16 * j + ql, cs = min(max(c - 8, 0), 48), kc0 = min(max(16 * j - 8, 0), 32);
    const int dcb = kc0 + 4 * quad - c + 15;
    bool sel1[4];
#pragma unroll
    for (int i = 0; i < 4; ++i) sel1[i] = (4 * quad + i) < (cs - kc0);
    const int koff = (quad * 64 + kc0 + ql) * 16;
    const int voff = 8192 + ((kc0 >> 2) + quad) * 512 + ql * 8;
    if (probe_mask & 1)
    for (int wi = vcu; wi < 256; wi += G) {
        const int b = wi >> 4, g = wi & 15, h = g >> 1, half = g & 1, r0 = 16 * half;
        const size_t rowblk0 = (size_t)(b * 8 + h) * 32;
        const bf16* Qb = Q + (size_t)b * QK_BSTRIDE + (size_t)h * 32 * 4096; const bf16* Kb = Qb + QK_KOFF;
        __syncthreads();
        int cur_hi = at_rs(r0 + 1) + 7;
        {
            const int lo = at_rs(r0);
            v4u t[9][2];
#pragma unroll
            for (int q = 0; q < 9; ++q) { const int rw = min(lo + q, cur_hi);
                t[q][0] = *(const v4u*)(Kb + (size_t)rw * 4096 + tid * 8); t[q][1] = *(const v4u*)(VT + (rowblk0 + rw) * 4096 + tid * 8); }
            const float tv = tid < 465 ? rpb[h * 465 + tid] : 0.f;
            __builtin_amdgcn_sched_barrier(0);
            if (tid < 465) tbl[tid] = tv * 1.4426950408889634f;
#pragma unroll
            for (int q = 0; q < 9; ++q) { const int rw = min(lo + q, cur_hi); LAS unsigned char* d = lds + (rw % AT_NSLOT) * AT_SLOT + tid * 16;
                *(LAS v4u*)d = t[q][0]; *(LAS v4u*)(d + 8192) = t[q][1]; }
        }
        bf16x8 qf[2];
#pragma unroll
        for (int ks = 0; ks < 2; ++ks) qf[ks] = *(const bf16x8*)(Qb + ((size_t)(r0 + rsub) * 8 + ks * 4 + quad) * 512 + c * 8);
        __syncthreads();
#pragma unroll 1
        for (int it = 0; it < 8; ++it) {
            const int ra = r0 + 2 * it, r = ra + rsub, rs = at_rs(r);
            const int nxt_hi = it < 7 ? at_rs(ra + 3) + 7 : cur_hi;
            v4u pre[2][2]; bf16x8 qn[2];
#pragma unroll
            for (int q = 0; q < 2; ++q) { const int rw = min(cur_hi + 1 + q, 31);
                pre[q][0] = *(const v4u*)(Kb + (size_t)rw * 4096 + tid * 8); pre[q][1] = *(const v4u*)(VT + (rowblk0 + rw) * 4096 + tid * 8); }
            { const int rn = min(r + 2, 31);
#pragma unroll
              for (int ks = 0; ks < 2; ++ks) qn[ks] = *(const bf16x8*)(Qb + ((size_t)rn * 8 + ks * 4 + quad) * 512 + c * 8); }
            const size_t tokq = (size_t)b * SEQ + r * 64 + c;
            f32x4 S[16];
            int sl = rs % AT_NSLOT;
#pragma unroll
            for (int s = 0; s < 8; ++s) {
                const LAS unsigned char* kp = lds + sl * AT_SLOT + koff;
#pragma unroll
                for (int h2 = 0; h2 < 2; ++h2) {
                    const bf16x8 k0 = *(const LAS bf16x8*)(kp + h2 * 256), k1 = *(const LAS bf16x8*)(kp + 4096 + h2 * 256);
                    f32x4 a = (f32x4){0.f, 0.f, 0.f, 0.f};
                    a = __builtin_amdgcn_mfma_f32_16x16x32_bf16(k0, qf[0], a, 0, 0, 0);
                    a = __builtin_amdgcn_mfma_f32_16x16x32_bf16(k1, qf[1], a, 0, 0, 0);
                    S[2 * s + h2] = a;
                }
                sl = sl + 1 == AT_NSLOT ? 0 : sl + 1;
            }
            float xs[8][4]; float mx = -1e30f;
            const LAS float* tb = tbl + (rs - r + 7) * 31 + dcb;
#pragma unroll
            for (int i = 0; i < 4; ++i) {
                const LAS float* tbi = tb + i + (sel1[i] ? 16 : 0);
#pragma unroll
                for (int s = 0; s < 8; ++s) { const float x = (sel1[i] ? S[2 * s + 1][i] : S[2 * s][i]) + tbi[s * 31]; xs[s][i] = x; mx = fmaxf(mx, x); }
            }
            mx = fmaxf(mx, __shfl_xor(mx, 16)); mx = fmaxf(mx, __shfl_xor(mx, 32));
            float sum = 0.f;
#pragma unroll
            for (int s = 0; s < 8; ++s)
#pragma unroll
                for (int i = 0; i < 4; ++i) { const float p = __builtin_amdgcn_exp2f(xs[s][i] - mx); sum += p; S[2 * s][i] = sel1[i] ? 0.f : p; S[2 * s + 1][i] = sel1[i] ? p : 0.f; }
            sum += __shfl_xor(sum, 16); sum += __shfl_xor(sum, 32);
            const float inv = 1.0f / sum;
            f32x4 O[4];
#pragma unroll
            for (int db = 0; db < 4; ++db) O[db] = (f32x4){0.f, 0.f, 0.f, 0.f};
            sl = rs % AT_NSLOT;
#pragma unroll
            for (int s = 0; s < 8; ++s) {
                v4u pw; pw.x = pg8::cvt_pk_bf16(S[2 * s][0], S[2 * s][1]); pw.y = pg8::cvt_pk_bf16(S[2 * s][2], S[2 * s][3]);
                pw.z = pg8::cvt_pk_bf16(S[2 * s + 1][0], S[2 * s + 1][1]); pw.w = pg8::cvt_pk_bf16(S[2 * s + 1][2], S[2 * s + 1][3]);
                const bf16x8 pb = __builtin_bit_cast(bf16x8, pw);
                const LAS unsigned char* vp = lds + sl * AT_SLOT + voff;
#pragma unroll
                for (int db = 0; db < 4; ++db) {
                    const int o = (db ^ (quad & 1)) * 128;
                    const v2u lo = *(const LAS v2u*)(vp + o), hi = *(const LAS v2u*)(vp + o + 2048);
                    O[db] = __builtin_amdgcn_mfma_f32_16x16x32_bf16(__builtin_bit_cast(bf16x8, (v4u){lo.x, lo.y, hi.x, hi.y}), pb, O[db], 0, 0, 0);
                }
                sl = sl + 1 == AT_NSLOT ? 0 : sl + 1;
            }
            bf16* op = CAT + tokq * 1024 + h * 64 + 4 * quad;
#pragma unroll
            for (int db = 0; db < 4; ++db) { v2u o; o.x = pg8::cvt_pk_bf16(O[db][0] * inv, O[db][1] * inv); o.y = pg8::cvt_pk_bf16(O[db][2] * inv, O[db][3] * inv); *(v2u*)(op + 16 * db) = o; }
            __syncthreads();
#pragma unroll
            for (int q = 0; q < 2; ++q) { const int rw = cur_hi + 1 + q;
                if (rw <= nxt_hi) { LAS unsigned char* d = lds + (rw % AT_NSLOT) * AT_SLOT + tid * 16; *(LAS v4u*)d = pre[q][0]; *(LAS v4u*)(d + 8192) = pre[q][1]; } }
            cur_hi = nxt_hi; qf[0] = qn[0]; qf[1] = qn[1];
            __syncthreads();
        }
    }
    const int gw = vcu * NWAVES + wave, NGW = G * NWAVES;
    if (probe_mask & 2)
    for (int wb = gw; wb < (M / 64) * 4; wb += NGW) {
        const int g = wb & 3, tb = wb >> 2;
        if (g == 0) pool_block<1>(P, CAT, tb, g, lane); else if (g == 1) pool_block<2>(P, CAT, tb, g, lane); else if (g == 2) pool_block<4>(P, CAT, tb, g, lane); else pool_block<8>(P, CAT, tb, g, lane);
    }
    __syncthreads();
}

struct Args { const float* in[16]; float* out; unsigned char* ws; };
__global__ void __launch_bounds__(NWAVES * 64, 2) mega_fwd(Args args) {
    extern __shared__ __attribute__((aligned(16))) unsigned char lds_raw[];
    cg::grid_group grid = cg::this_grid();
    LAS unsigned char* lds = (LAS unsigned char*)lds_raw;
    const int tid = threadIdx.x, lane = tid & 63, wave = __builtin_amdgcn_readfirstlane(tid >> 6);
    const int G = gridDim.x, bx = blockIdx.x, vcu = (G % 8 == 0) ? (bx % 8) * (G / 8) + bx / 8 : bx;
    const int gw = vcu * NWAVES + wave, NGW = G * NWAVES;
    unsigned char* ws = args.ws;
    float* ssq = (float*)(ws + WS_SSQ); bf16* XB = (bf16*)(ws + WS_XB); bf16* HB = (bf16*)(ws + WS_H);
    bf16 *QB = (bf16*)args.out, *KB = (bf16*)args.out + QK_KOFF, *PB = (bf16*)(ws + WS_P), *VT = (bf16*)(ws + WS_VT), *CAT = (bf16*)(ws + WS_CAT);
    float* xo = args.out;

    if (tid < 64) ((LAS unsigned*)(lds + MISC_OFF))[tid] = 0u;
    unsigned* barw = (unsigned*)(ws + WS_BAR);
    if (bx == 0) for (int i = tid; i < XB_ALL_WORDS; i += NWAVES * 64) barw[i] = 0u;
    if (bx == 0 && tid < 8 * 64) ((unsigned*)(ws + WS_GBAR))[tid] = 0u;
    grid.sync();
    const XcdBarrier bar = xcd_barrier_post(barw, (volatile LAS unsigned*)(lds + MISC_OFF));
#pragma unroll 1
    for (int rep = 0; rep < 1 + (DUP_PRO ? 2 : 0); ++rep) {
        int pr = rep ? DUP_PRO : 3; asm volatile("" : "+s"(pr));
        prologue(args.in, ws, gw, NGW, lane, pr);
        xcd_barrier(bar);
    }
    volatile LAS unsigned* const lmw = (volatile LAS unsigned*)(lds + MISC_OFF) + 17;
    if (tid == 0) {
        unsigned ok = (G == 256) ? 1u : 0u;
        for (unsigned j = 0; j < 16u && ok; ++j) { const unsigned c = xb_ld(&barw[XB_XCNT(j)]); if (c == 0u) continue; if (c != 32u) { ok = 0u; break; }
            unsigned whole = 0u; for (unsigned g = 0; g < 8u; ++g) whole |= (xb_ld(&barw[XB_GX(j * 8u + g)]) == 32u) ? 1u : 0u; if (!whole) ok = 0u; }
        lmw[0] = ok;
    }
    __syncthreads();
    const bool lm = lmw[0] != 0u;
#define GRID_SYNC() xcd_barrier(bar, lm)
#define LAUNDER_L() int ll = l; asm volatile("" : "+s"(ll)); const LayerW w = layer_w(args.in, ws, ll)
#pragma unroll 1
    for (int l = 0; l < DEPTH; ++l) {
        {
            LAUNDER_L();
            pg8::Gemm g{XB, w.GU1, M, 2 * FF, D}; pg8::StaticOrder S; S.init(M, 2 * FF, G, bx);
            pg8::EpiSwiglu E{HB, ssq + (size_t)(3 * ll) * M, FF};
            pg8::gemm_phase<pg8::EpiSwiglu, pg8::StaticOrder, true, true>(lds, g, S, E);
#if DUP_UP
            GRID_SYNC();
            pg8::gemm_phase<pg8::EpiSwiglu, pg8::StaticOrder, true, true>(lds, g, S, E);
#endif
        }
        GRID_SYNC();
#pragma unroll 1
        for (int rep = 0; rep < 1 + DUP_DOWN; ++rep) {
            LAUNDER_L();
            if (rep) GRID_SYNC();
            pg8::Gemm g{HB, w.D1, M, D, FF}; pg8::StaticOrder S; S.init(M, D, G, bx);
#if DUP_DOWN_NULL
            if (rep) { pg8::EpiNull EN{(float*)(ws + WS_END)}; pg8::gemm_phase<pg8::EpiNull, pg8::StaticOrder, true, true>(lds, g, S, EN); continue; }
#endif
            pg8::EpiRes E{XB, rep ? (float*)(ws + WS_END) : ssq + (size_t)(3 * ll + 1) * M, rep ? 0.0f : 0.5f};
            pg8::gemm_phase<pg8::EpiRes, pg8::StaticOrder, true, true>(lds, g, S, E);
        }
        GRID_SYNC();
#pragma unroll 1
        for (int rep = 0; rep < 1 + DUP_IN; ++rep) {
            LAUNDER_L();
            if (rep) GRID_SYNC();
            {
                pg8::Gemm g{XB, w.WIN, M, 1536, D}; pg8::WinOrder S; S.init(M, G, bx);
                pg8::EpiZV E{pg8::EpiZ{QB, PB, ssq + (size_t)(3 * ll + 1) * M, QK_KOFF, QK_BSTRIDE}, pg8::EpiVT{VT, ssq + (size_t)(3 * ll + 1) * M}};
                pg8::gemm_phase<pg8::EpiZV, pg8::WinOrder, true, true>(lds, g, S, E);
            }
        }
        GRID_SYNC();
#pragma unroll 1
        for (int rep = 0; rep < 1 + DUP_ATTN; ++rep) {
            LAUNDER_L();
            int t2 = threadIdx.x; asm volatile("" : "+v"(t2));
            if (rep) GRID_SYNC();
            int pm_ = rep ? ATT_PROBE_MASK : 3; asm volatile("" : "+s"(pm_));
            attn_pool_phase(lds, QB, KB, VT, PB, CAT, w.rpb, vcu, G, __builtin_amdgcn_readfirstlane(t2 >> 6), t2 & 63, t2, pm_);
        }
        GRID_SYNC();
#pragma unroll 1
        for (int rep = 0; rep < 1 + DUP_WOUT; ++rep) {
            LAUNDER_L();
            if (rep) GRID_SYNC();
            pg8::Gemm g{CAT, w.WOUT, M, D, D}; pg8::StaticOrder S; S.init(M, D, G, bx);
            pg8::EpiRes E{XB, rep ? (float*)(ws + WS_END) : ssq + (size_t)(3 * ll + 2) * M, rep ? 0.0f : 1.0f};
            pg8::gemm_phase<pg8::EpiRes, pg8::StaticOrder, true, true>(lds, g, S, E);
        }
        GRID_SYNC();
        {
            LAUNDER_L();
            pg8::Gemm g{XB, w.GU2, M, 2 * FF, D}; pg8::StaticOrder S; S.init(M, 2 * FF, G, bx);
            pg8::EpiSwiglu E{HB, ssq + (size_t)(3 * ll + 2) * M, FF};
            pg8::gemm_phase<pg8::EpiSwiglu, pg8::StaticOrder, true, true>(lds, g, S, E);
        }
        GRID_SYNC();
        {
            LAUNDER_L();
            pg8::Gemm g{HB, w.D2, M, D, FF}; pg8::StaticOrder S; S.init(M, D, G, bx);
            if (ll == DEPTH - 1 && G == 256) {
                pg8::EpiResFinal EF{XB, ssq + (size_t)(3 * DEPTH) * M, (unsigned*)(ws + WS_PCNT), args.in[15], xo, 0.5f};
                pg8::gemm_phase<pg8::EpiResFinal, pg8::StaticOrder, true, true>(lds, g, S, EF);
            } else {
                pg8::EpiRes E{XB, ssq + (size_t)(3 * ll + 3) * M, 0.5f};
                pg8::gemm_phase<pg8::EpiRes, pg8::StaticOrder, true, true>(lds, g, S, E);
                GRID_SYNC();
            }
        }
    }
    if (G != 256) {
        int t2 = threadIdx.x; asm volatile("" : "+v"(t2)); const int ln = t2 & 63, gwf = vcu * NWAVES + __builtin_amdgcn_readfirstlane(t2 >> 6);
        const float* gn = args.in[15]; const float* sf = ssq + (size_t)(3 * DEPTH) * M;
        for (int m = gwf; m < M; m += NGW) {
            const float rs = pg8::rstd_of(sf[m]); f32x4* xr = (f32x4*)(xo + (size_t)m * D) + ln; const f32x4* gr = (const f32x4*)gn + ln;
            const v2u* hr = (const v2u*)(XB + (size_t)m * D) + ln;
#pragma unroll
            for (int jj = 0; jj < 4; ++jj) { const v2u hw = hr[64 * jj];
                const f32x4 v = (f32x4){bflo(hw.x), bfhi(hw.x), bflo(hw.y), bfhi(hw.y)};
                xr[64 * jj] = v * rs * gr[64 * jj]; }
        }
    }
}

extern "C" void kernel_launch(void* const* d_in, const int* in_sizes, int n_in, void* d_out, int out_size, void* d_ws, size_t ws_size, hipStream_t stream) {
    static int grid = 0;
    if (grid == 0) {
        if (n_in != 16 || in_sizes[0] != M * D || out_size != M * D || ws_size < WS_END) { fprintf(stderr, "kernel_launch: unexpected shapes (n_in %d, in0 %d, out %d, ws %zu)\n", n_in, n_in > 0 ? in_sizes[0] : -1, out_size, ws_size); grid = -1; return; }
        int dev = 0, cus = 0, per_cu = 0;
        if (hipGetDevice(&dev) != hipSuccess || hipDeviceGetAttribute(&cus, hipDeviceAttributeMultiprocessorCount, dev) != hipSuccess) { grid = -1; return; }
        if (hipFuncSetAttribute((const void*)mega_fwd, hipFuncAttributeMaxDynamicSharedMemorySize, LDS_BYTES) != hipSuccess) { fprintf(stderr, "kernel_launch: hipFuncSetAttribute failed\n"); grid = -1; return; }
        if (hipOccupancyMaxActiveBlocksPerMultiprocessor(&per_cu, (const void*)mega_fwd, NWAVES * 64, LDS_BYTES) != hipSuccess || per_cu < 1) { fprintf(stderr, "kernel_launch: occupancy query gave %d\n", per_cu); per_cu = 1; }
        (void)hipGetLastError();
        grid = cus * 1;
    }
    if (grid < 0) return;
    Args a{};
    for (int i = 0; i < 16; ++i) a.in[i] = (const float*)d_in[i];
    a.out = (float*)d_out; a.ws = (unsigned char*)d_ws;
    void* kargs[] = {&a};
    const hipError_t e = hipLaunchCooperativeKernel((const void*)mega_fwd, dim3(grid), dim3(NWAVES * 64), kargs, LDS_BYTES, stream);
    if (e != hipSuccess) fprintf(stderr, "kernel_launch: cooperative launch failed: %s (grid %d)\n", hipGetErrorString(e), grid);
}
```
